# Optimizing an MI355X kernel written in HIP

```python
import jax, jax.numpy as jnp
from jax import lax
import numpy as np

D_MODEL = 2048
BATCH = 4
SEQ = 2048
DEPTH = 4

HEAD_DIM = 64
ATTN_HEADS = 16
ATTN_KV_HEADS = 4
ATTN_GROUP = ATTN_HEADS // ATTN_KV_HEADS
ATTN_WIDTH = ATTN_HEADS * HEAD_DIM
KV_WIDTH = ATTN_KV_HEADS * HEAD_DIM
WINDOW = 128
BLOCK = 128

RWKV_HEADS = 16
RWKV_HEAD_SIZE = 64
RWKV_WIDTH = RWKV_HEADS * RWKV_HEAD_SIZE
DECAY_RANK = 64
ICLR_RANK = 64
VRES_RANK = 32
GATE_RANK = 160
SHIFT_WIDTH = 3 * RWKV_WIDTH + DECAY_RANK + ICLR_RANK + GATE_RANK

FFN_HIDDEN = -(-8 * D_MODEL // (3 * 256)) * 256

IN_SPLITS = (ATTN_WIDTH, KV_WIDTH, KV_WIDTH, SHIFT_WIDTH, D_MODEL, D_MODEL)
N_IN = sum(IN_SPLITS)

NORM_EPS = 1e-5
LNX_EPS = 64e-5

kernel_name = 'hybrid_swa_sink_alibi_rwkv7_gated_swiglu'


def split_last(t, sizes):
    idx = np.cumsum(np.array(sizes))[:-1].tolist()
    return jnp.split(t, idx, axis=-1)


def rms_norm(x, g):
    x32 = x.astype(jnp.float32)
    y = x32 * lax.rsqrt(jnp.mean(x32 * x32, axis=-1, keepdims=True) + NORM_EPS)
    return (y * g.astype(jnp.float32)).astype(x.dtype)


def token_shift_mix(p, mu):
    prev = jnp.pad(p, ((0, 0), (1, 0), (0, 0)))[:, :-1]
    return p + (prev - p) * mu


def alibi_slopes():
    return jnp.exp2(-8.0 * jnp.arange(1, ATTN_HEADS + 1, dtype=jnp.float32) / ATTN_HEADS)


def sliding_window_attention(q, k, v, sinks):
    B, T, _ = q.shape
    nb = T // BLOCK
    qb = q.reshape(B, nb, BLOCK, ATTN_KV_HEADS, ATTN_GROUP, HEAD_DIM)
    kb = k.reshape(B, nb, BLOCK, ATTN_KV_HEADS, HEAD_DIM)
    vb = v.reshape(B, nb, BLOCK, ATTN_KV_HEADS, HEAD_DIM)

    def with_prev(t):
        prev = jnp.concatenate([jnp.zeros_like(t[:, :1]), t[:, :-1]], axis=1)
        return jnp.concatenate([prev, t], axis=2)

    kw, vw = with_prev(kb), with_prev(vb)
    s = jnp.einsum('bnqkgd,bnskd->bnkgqs', qb, kw).astype(jnp.float32) * (HEAD_DIM ** -0.5)
    qi = jnp.arange(BLOCK)[:, None]
    kj = jnp.arange(2 * BLOCK)[None, :]
    dist = BLOCK + qi - kj
    kpos = (jnp.arange(nb)[:, None] - 1) * BLOCK + jnp.arange(2 * BLOCK)[None, :]
    valid = ((dist >= 0) & (dist < WINDOW))[None] & (kpos >= 0)[:, None, :]
    slopes = alibi_slopes().reshape(ATTN_KV_HEADS, ATTN_GROUP)
    s = s - slopes[:, :, None, None] * dist.astype(jnp.float32)
    s = jnp.where(valid[None, :, None, None], s, -jnp.inf)
    sink = jnp.broadcast_to(sinks.astype(jnp.float32).reshape(ATTN_KV_HEADS, ATTN_GROUP, 1, 1),
                            s.shape[:-1] + (1,))
    p = jax.nn.softmax(jnp.concatenate([s, sink], axis=-1), axis=-1)[..., :-1]
    o = jnp.einsum('bnkgqs,bnskd->bnqkgd', p.astype(v.dtype), vw)
    return o.reshape(B, T, ATTN_WIDTH)


def rwkv7_time_mix(r, k, v, dw, da, dg, decay_up, decay_bias, iclr_up, iclr_bias, gate_up,
                   k_k, k_a, r_k, lnx_w, lnx_b):
    B, T, C = r.shape
    H, N = RWKV_HEADS, RWKV_HEAD_SIZE
    f32 = jnp.float32
    w_log = -jax.nn.softplus(-(decay_bias + jnp.tanh(dw) @ decay_up).astype(f32)) - 0.5
    decay = jnp.exp(-jnp.exp(w_log))
    a = jax.nn.sigmoid((iclr_bias + da @ iclr_up).astype(f32))
    g = jax.nn.sigmoid(dg) @ gate_up
    kk = (k * k_k).astype(f32).reshape(B, T, H, N)
    kk = kk / jnp.maximum(jnp.sqrt(jnp.sum(kk * kk, axis=-1, keepdims=True)), 1e-12)
    k_mod = k.astype(f32) * (1.0 + (a - 1.0) * k_a.astype(f32))

    def heads_tm(t):
        return t.astype(f32).reshape(B, T, H, N).transpose(1, 0, 2, 3)

    def step(S, inp):
        r_t, w_t, k_t, v_t, kk_t, a_t = inp
        sa = jnp.einsum('bhij,bhj->bhi', S, -kk_t)
        S = (S * w_t[:, :, None, :] + sa[..., None] * (kk_t * a_t)[:, :, None, :]
             + v_t[..., None] * k_t[:, :, None, :])
        return S, jnp.einsum('bhij,bhj->bhi', S, r_t)

    S0 = jnp.zeros((B, H, N, N), f32)
    _, y = lax.scan(step, S0, (heads_tm(r), heads_tm(decay), heads_tm(k_mod), heads_tm(v),
                               kk.transpose(1, 0, 2, 3), heads_tm(a)))
    y = y.transpose(1, 0, 2, 3)
    mean = jnp.mean(y, axis=-1, keepdims=True)
    var = jnp.mean(jnp.square(y - mean), axis=-1, keepdims=True)
    y = ((y - mean) * lax.rsqrt(var + LNX_EPS)).reshape(B, T, C)
    y = y * lnx_w.astype(f32) + lnx_b.astype(f32)
    r4 = r.astype(f32).reshape(B, T, H, N)
    bonus = jnp.sum(r4 * k_mod.reshape(B, T, H, N) * r_k.astype(f32), axis=-1, keepdims=True)
    y = y + (bonus * v.astype(f32).reshape(B, T, H, N)).reshape(B, T, C)
    return y.astype(r.dtype) * g


def setup_inputs(seed: int = 0) -> dict:
    key = jax.random.key(seed)
    ks = jax.random.split(key, 32)
    L, D, C = DEPTH, D_MODEL, RWKV_WIDTH

    def nrm(k, shape, scale):
        return jax.random.normal(k, shape, jnp.float32) * scale

    def uni(k, shape, lo, hi):
        return jax.random.uniform(k, shape, jnp.float32, lo, hi)

    return {
        'x': nrm(ks[0], (BATCH, SEQ, D), 1.0),
        'norm_mix': 1.0 + nrm(ks[1], (L, D), 0.02),
        'norm_ffn': 1.0 + nrm(ks[2], (L, D), 0.02),
        'norm_final': 1.0 + nrm(ks[3], (D,), 0.02),
        'w_in': nrm(ks[4], (L, D, N_IN), D ** -0.5),
        'attn_sinks': nrm(ks[5], (L, ATTN_HEADS), 0.5),
        'tshift_mix': uni(ks[6], (L, SHIFT_WIDTH), 0.0, 1.0),
        'decay_up': nrm(ks[7], (L, DECAY_RANK, C), 0.1 * DECAY_RANK ** -0.5),
        'decay_bias': uni(ks[8], (L, C), -5.0, 1.0),
        'iclr_up': nrm(ks[9], (L, ICLR_RANK, C), 0.1 * ICLR_RANK ** -0.5),
        'iclr_bias': nrm(ks[10], (L, C), 0.1),
        'gate_up': nrm(ks[11], (L, GATE_RANK, C), GATE_RANK ** -0.5),
        'k_k': 0.85 + nrm(ks[12], (L, C), 0.05),
        'k_a': 1.0 + nrm(ks[13], (L, C), 0.05),
        'r_k': nrm(ks[14], (L, RWKV_HEADS, RWKV_HEAD_SIZE), 0.1),
        'lnx_w': 1.0 + nrm(ks[15], (L, C), 0.02),
        'lnx_b': nrm(ks[16], (L, C), 0.02),
        'vres_down': nrm(ks[17], (L - 1, D, VRES_RANK), D ** -0.5),
        'vres_mix': uni(ks[18], (L - 1, VRES_RANK), 0.0, 1.0),
        'vres_up': nrm(ks[19], (L - 1, VRES_RANK, C), VRES_RANK ** -0.5),
        'vres_bias': 1.0 + nrm(ks[20], (L - 1, C), 0.1),
        'w_branch_attn': nrm(ks[21], (L, ATTN_WIDTH, D), ATTN_WIDTH ** -0.5),
        'w_branch_rwkv': nrm(ks[22], (L, C, D), C ** -0.5),
        'w_out': nrm(ks[23], (L, D, D), D ** -0.5),
        'ffn_gate': nrm(ks[24], (L, D, FFN_HIDDEN), D ** -0.5),
        'ffn_up': nrm(ks[25], (L, D, FFN_HIDDEN), D ** -0.5),
        'ffn_down': nrm(ks[26], (L, FFN_HIDDEN, D), FFN_HIDDEN ** -0.5),
    }


def reference(x, norm_mix, norm_ffn, norm_final, w_in, attn_sinks, tshift_mix, decay_up,
              decay_bias, iclr_up, iclr_bias, gate_up, k_k, k_a, r_k, lnx_w, lnx_b,
              vres_down, vres_mix, vres_up, vres_bias, w_branch_attn, w_branch_rwkv, w_out,
              ffn_gate, ffn_up, ffn_down):
    v_first = None
    for l in range(DEPTH):
        h = rms_norm(x, norm_mix[l])
        p = h @ w_in[l]
        q, k_att, v_att, rw, gate_a, gate_b = split_last(p, IN_SPLITS)
        rw = token_shift_mix(rw, tshift_mix[l])
        r, k, v, dw, da, dg = split_last(
            rw, (RWKV_WIDTH, RWKV_WIDTH, RWKV_WIDTH, DECAY_RANK, ICLR_RANK, GATE_RANK))
        if l == 0:
            v_first = v
        else:
            dv = token_shift_mix(h @ vres_down[l - 1], vres_mix[l - 1])
            v = v + (v_first - v) * jax.nn.sigmoid(vres_bias[l - 1] + dv @ vres_up[l - 1])
        y_attn = sliding_window_attention(q, k_att, v_att, attn_sinks[l])
        y_rwkv = rwkv7_time_mix(r, k, v, dw, da, dg, decay_up[l], decay_bias[l], iclr_up[l],
                                iclr_bias[l], gate_up[l], k_k[l], k_a[l], r_k[l],
                                lnx_w[l], lnx_b[l])
        merged = (jax.nn.sigmoid(gate_a) * (y_attn @ w_branch_attn[l])
                  + jax.nn.sigmoid(gate_b) * (y_rwkv @ w_branch_rwkv[l]))
        x = x + merged @ w_out[l]
        h = rms_norm(x, norm_ffn[l])
        x = x + (jax.nn.silu(h @ ffn_gate[l]) * (h @ ffn_up[l])) @ ffn_down[l]
    return rms_norm(x, norm_final)
```

```cpp
#include <hip/hip_runtime.h>
#include <hip/hip_cooperative_groups.h>
#include <cstdio>
namespace cg = cooperative_groups;

#ifndef FUSED
#define FUSED 1
#endif

#ifndef REP_P0
#define REP_P0 1
#endif
#ifndef REP_INPROJ
#define REP_INPROJ 1
#endif
#ifndef REP_PREP
#define REP_PREP 1
#endif
#ifndef REP_ATTN
#define REP_ATTN 1
#endif
#ifndef REP_SCAN
#define REP_SCAN 1
#endif
#ifndef REP_POST
#define REP_POST 1
#endif
#ifndef REP_BR
#define REP_BR 1
#endif
#ifndef REP_GU
#define REP_GU 1
#endif

#define LAS __attribute__((address_space(3)))
typedef unsigned short bf16_t;
typedef short bf16x8 __attribute__((ext_vector_type(8)));
typedef float f32x2 __attribute__((ext_vector_type(2)));
typedef float f32x4 __attribute__((ext_vector_type(4)));
typedef float f32x16 __attribute__((ext_vector_type(16)));
typedef unsigned u32x2 __attribute__((ext_vector_type(2)));
typedef unsigned u32x4 __attribute__((ext_vector_type(4)));
typedef __bf16 nbf2 __attribute__((ext_vector_type(2)));

constexpr int M_ = 8192, D_ = 2048, T_ = 2048, C_ = 1024, FH_ = 5632, NP_ = 9216, NIN_ = 8992, PRWW_ = 3584;
constexpr float NORM_EPS = 1e-5f, LNX_EPS = 64e-5f;

constexpr size_t OFF_WIN = 0, OFF_WBA = OFF_WIN + (size_t)NP_ * D_, OFF_WBR = OFF_WBA + (size_t)D_ * C_, OFF_WO = OFF_WBR + (size_t)D_ * C_,
                 OFF_WGU = OFF_WO + (size_t)D_ * D_, OFF_WD = OFF_WGU + (size_t)2 * FH_ * D_, LSTRIDE = OFF_WD + (size_t)D_ * FH_;
constexpr int UPS_L = 1024 * 320;
constexpr int UPS_D = 0, UPS_I = 65536, UPS_G = 131072, UPS_V = 294912;
constexpr size_t ARR = (size_t)M_ * C_;

constexpr size_t WS_W = 0;
constexpr size_t WS_UPS = WS_W + 4 * LSTRIDE * 2;
constexpr size_t WS_XRES = WS_UPS + (size_t)4 * UPS_L * 2;
constexpr size_t WS_XB = WS_XRES + (size_t)M_ * D_ * 4;
constexpr size_t WS_SS = WS_XB + (size_t)M_ * D_ * 2;
constexpr size_t WS_QB = WS_SS + (size_t)9 * M_ * 32 * 4;
constexpr size_t WS_KB = WS_QB + ARR * 2;
constexpr size_t WS_VT = WS_KB + (size_t)M_ * 256 * 2;
constexpr size_t WS_SG = WS_VT + (size_t)M_ * 256 * 2;
constexpr size_t WS_VFIRST = WS_SG + (size_t)M_ * 4096 * 2;
constexpr size_t WS_G = WS_VFIRST + ARR * 4;
constexpr size_t WS_YA = WS_G + ARR * 2;
constexpr size_t WS_YR = WS_YA + ARR * 2;
constexpr size_t WS_MRG = WS_YR + ARR * 2;
constexpr size_t WS_PRW = WS_MRG + (size_t)M_ * D_ * 2;
constexpr size_t WS_SCAN = WS_PRW + (size_t)M_ * PRWW_ * 4;
constexpr size_t WS_BAR = WS_SCAN + 6 * ARR * 4;
constexpr size_t WS_END = WS_BAR + 16384;
static_assert((size_t)M_ * FH_ * 2 <= (size_t)M_ * PRWW_ * 4, "ACT alias");

constexpr int LDS_STAGE = 131072, LDS_RST = LDS_STAGE + 16, LDS_BYTES = LDS_RST + 6 * 1024;

struct Params { const float* in[27]; float* out; unsigned char* ws; int ph_lo, ph_hi; };
struct Ctx { int tid, bx, G; };

__device__ __forceinline__ unsigned pk_bf16(float lo, float hi) { f32x2 v = {lo, hi}; nbf2 b = __builtin_convertvector(v, nbf2); return __builtin_bit_cast(unsigned, b); }
__device__ __forceinline__ u32x2 pk4_bf16(f32x4 v) { u32x2 r; r.x = pk_bf16(v[0], v[1]); r.y = pk_bf16(v[2], v[3]); return r; }
__device__ __forceinline__ f32x4 unpk4_bf16(u32x2 w) { f32x4 r; r[0] = __uint_as_float(w.x << 16); r[1] = __uint_as_float(w.x & 0xffff0000u); r[2] = __uint_as_float(w.y << 16); r[3] = __uint_as_float(w.y & 0xffff0000u); return r; }
__device__ __forceinline__ float sigm(float x) { return __builtin_amdgcn_rcpf(1.0f + __expf(-x)); }
__device__ __forceinline__ float tanh_fast(float x) { return 1.0f - 2.0f * __builtin_amdgcn_rcpf(1.0f + __expf(2.0f * x)); }
__device__ __forceinline__ f32x4 sigm4(f32x4 v) { f32x4 r; r[0] = sigm(v[0]); r[1] = sigm(v[1]); r[2] = sigm(v[2]); r[3] = sigm(v[3]); return r; }
__device__ __forceinline__ float dot4(f32x4 a, f32x4 b) { return (a[0] * b[0] + a[1] * b[1]) + (a[2] * b[2] + a[3] * b[3]); }
__device__ __forceinline__ float dppf(float x, const int ctrl) { return x; }
#define DPP_ADD(x, ctrl) ((x) + __int_as_float(__builtin_amdgcn_update_dpp(0, __float_as_int(x), (ctrl), 0xF, 0xF, false)))
__device__ __forceinline__ float red16(float x) { x = DPP_ADD(x, 0xB1); x = DPP_ADD(x, 0x4E); x = DPP_ADD(x, 0x141); x = DPP_ADD(x, 0x140); return x; }

__device__ __forceinline__ unsigned prw_row(int row) { return (unsigned)(row >> 4) * (unsigned)(PRWW_ * 16) + (unsigned)(row & 15) * 16u; }
__device__ __forceinline__ unsigned prw_col(int col) { return (unsigned)(col >> 4) * 256u + (unsigned)(col & 15); }
__device__ __forceinline__ unsigned tix(int row, int col) { return (unsigned)(row >> 4) * 16384u + (unsigned)(col >> 4) * 256u + (unsigned)(row & 15) * 16u + (unsigned)(col & 15); }
__device__ __forceinline__ size_t tixa(size_t r, int k, int K) { return ((r >> 4) * (size_t)(K >> 5) + (size_t)(k >> 5)) * 512 + (size_t)((int)(r & 15) * 32 + (k & 31)); }
__device__ __forceinline__ float row_ss(const float* ss, int row, int fq) {
    const f32x4 a = *(const f32x4*)(ss + (size_t)row * 32 + fq * 8), b = *(const f32x4*)(ss + (size_t)row * 32 + fq * 8 + 4);
    float s = ((a[0] + a[1]) + (a[2] + a[3])) + ((b[0] + b[1]) + (b[2] + b[3]));
    s += __shfl_xor(s, 16); s += __shfl_xor(s, 32); return s;
}

namespace pg8 {
constexpr int BM = 256, BK = 64, HALF = 128, HTB = HALF * BK * 2, STAGE_BYTES = 8 * HTB, NXCD = 8, WGM = 8;
__device__ __forceinline__ int lds_byte(int r, int c) { const int st = (r >> 4) * 2 + (c >> 5), rr = r & 15, cc = c & 31, ob = rr * 64 + cc * 2; return st * 1024 + (ob ^ (((ob >> 9) & 1) << 5)); }
__device__ __forceinline__ void stage_rc(int b, int& R, int& Cc) { const int st = b / 1024, sb = b % 1024, swz = sb ^ (((sb >> 9) & 1) << 5); R = (st >> 1) * 16 + swz / 64; Cc = (st & 1) * 32 + (swz % 64) / 2; }
struct Unit { int pm, pn, idx; };
struct Gemm { const bf16_t* A; const bf16_t* Bt; int M, N, K; };
struct StaticOrder {
    int nM, nN, nwg, G, c;
    __device__ void init(int M, int N, int G_, int c_) { nM = M / BM; nN = N / BM; nwg = nM * nN; G = G_; c = c_; }
    __device__ bool next(int i, Unit& u) const {
        const long L = (long)i * G + c; if (L >= nwg) return false;
        int wgid = (int)L; { const int q = nwg / NXCD, r = nwg % NXCD, xcd = wgid % NXCD, off = wgid / NXCD; wgid = (xcd < r ? xcd * (q + 1) : r * (q + 1) + (xcd - r) * q) + off; }
        const int nig = WGM * nN, gid = wgid / nig, fm = gid * WGM, gsz = (nM - fm) < WGM ? (nM - fm) : WGM;
        u.pm = fm + ((wgid % nig) % gsz); u.pn = (wgid % nig) / gsz; u.idx = i; return true;
    }
};

struct PairOrder : StaticOrder {
    __device__ bool next(int i, Unit& u) const { if (!StaticOrder::next(i >> 1, u)) return false; if (i & 1) { u.pm += 32; u.pn += 8; } return true; }
};

template <class Epi, class Sched>
__device__ __forceinline__ void gemm_phase(const Ctx cx, LAS unsigned char* lds, const Gemm g, const Sched& S, const Epi& E) {
    const int tid = cx.tid, wid = __builtin_amdgcn_readfirstlane(tid >> 6), lane = tid & 63, wr = wid >> 2, wc = wid & 3, fr = lane & 15, fq = lane >> 4;
    const int K = g.K, nt = K / BK;
    unsigned voffA[2];
#pragma unroll
    for (int i = 0; i < 2; ++i) { int R, Cc; stage_rc(tid * 16 + i * 8192, R, Cc); voffA[i] = (unsigned)(((R >> 4) * (K >> 5) + (Cc >> 5)) * 512 + (R & 15) * 32 + (Cc & 31)) * 2u; }
    const size_t kstep = (size_t)(2 * 512 * 2);
    const size_t hstep = (size_t)HALF * K * 2;
    const size_t tstep = 2 * hstep;
    const unsigned ldsw = (unsigned)wid * 1024u;
    const int aoff = lds_byte(wr * 64 + fr, fq * 8), boff = lds_byte(wc * 32 + fr, fq * 8);
#define PG8_SA(b, h) (((b) * 2 + (h)) * HTB)
#define PG8_SB(b, h) ((4 + (b) * 2 + (h)) * HTB)
#define PG8_STAGE(bufoff, gbase) do { _Pragma("unroll") for (int _i = 0; _i < 2; ++_i) \
        __builtin_amdgcn_global_load_lds((const unsigned*)((const char*)(gbase) + voffA[_i]), (LAS unsigned*)(lds + (bufoff) + ldsw + _i * 8192), 16, 0, 0); } while (0)
#define PG8_LDA(dst, b, h) do { _Pragma("unroll") for (int m = 0; m < 4; ++m) _Pragma("unroll") for (int k = 0; k < 2; ++k) dst[m][k] = *(const LAS bf16x8*)(lds + PG8_SA(b, h) + aoff + m * 2048 + k * 1024); } while (0)
#define PG8_LDB(dst, b, h) do { _Pragma("unroll") for (int n = 0; n < 2; ++n) _Pragma("unroll") for (int k = 0; k < 2; ++k) dst[n][k] = *(const LAS bf16x8*)(lds + PG8_SB(b, h) + boff + n * 2048 + k * 1024); } while (0)
#define PG8_MMA(ai, bj, At, Bt) do { __builtin_amdgcn_s_setprio(1); _Pragma("unroll") for (int m = 0; m < 4; ++m) _Pragma("unroll") for (int n = 0; n < 2; ++n) _Pragma("unroll") for (int k = 0; k < 2; ++k) \
        acc[ai][bj][m][n] = __builtin_amdgcn_mfma_f32_16x16x32_bf16(Bt[n][k], At[m][k], acc[ai][bj][m][n], 0, 0, 0); __builtin_amdgcn_s_setprio(0); } while (0)
#define PG8_WAIT_V(n) asm volatile("s_waitcnt vmcnt(" #n ")" ::: "memory")
#define PG8_WAIT_L(n) asm volatile("s_waitcnt lgkmcnt(" #n ")" ::: "memory")
#define PG8_BAR __builtin_amdgcn_s_barrier()
#define PG8_SCHED __builtin_amdgcn_sched_barrier(0)
    Unit cur, nxt; int ui = 0;
    if (!S.next(0, cur)) return;
    f32x4 acc[2][2][4][2];
#pragma unroll
    for (int a = 0; a < 2; ++a)
#pragma unroll
        for (int b = 0; b < 2; ++b)
#pragma unroll
            for (int m = 0; m < 4; ++m)
#pragma unroll
                for (int n = 0; n < 2; ++n) acc[a][b][m][n] = (f32x4){0.f, 0.f, 0.f, 0.f};
    bf16x8 At[4][2], B0[2][2], B1[2][2];
    const char* cA = (const char*)g.A + (size_t)cur.pm * tstep; const char* cB = (const char*)g.Bt + (size_t)cur.pn * tstep;
    PG8_STAGE(PG8_SB(0, 0), cB); PG8_STAGE(PG8_SA(0, 0), cA); PG8_STAGE(PG8_SB(0, 1), cB + hstep); PG8_STAGE(PG8_SA(0, 1), cA + hstep);
    if (wr == 1) PG8_BAR;
    PG8_WAIT_V(4); PG8_BAR;
    PG8_STAGE(PG8_SB(1, 0), cB + kstep); PG8_STAGE(PG8_SA(1, 0), cA + kstep); PG8_STAGE(PG8_SB(1, 1), cB + hstep + kstep);
    PG8_WAIT_V(6); PG8_BAR;
    for (;;) {
        const bool has_next = S.next(ui + 1, nxt);
        const char* nA = has_next ? (const char*)g.A + (size_t)nxt.pm * tstep : cA; const char* nB = has_next ? (const char*)g.Bt + (size_t)nxt.pn * tstep : cB;
        for (int t = 0; t < nt; t += 2) {
            const bool last = (t == nt - 2);
            const char* a1 = cA + (size_t)(t + 1) * kstep;
            const char* a2 = last ? nA : cA + (size_t)(t + 2) * kstep; const char* b2 = last ? nB : cB + (size_t)(t + 2) * kstep;
            const char* a3 = a2 + kstep; const char* b3 = b2 + kstep;
            PG8_LDB(B0, 0, 0); PG8_SCHED; PG8_LDA(At, 0, 0); PG8_STAGE(PG8_SA(1, 1), a1 + hstep);
            PG8_WAIT_L(8); PG8_BAR; PG8_WAIT_L(0); PG8_MMA(0, 0, At, B0); PG8_BAR; PG8_SCHED;
            PG8_LDB(B1, 0, 1); PG8_STAGE(PG8_SB(0, 0), b2);
            PG8_BAR; PG8_WAIT_L(0); PG8_MMA(0, 1, At, B1); PG8_BAR;
            PG8_LDA(At, 0, 1); PG8_STAGE(PG8_SA(0, 0), a2);
            PG8_BAR; PG8_WAIT_L(0); PG8_MMA(1, 0, At, B0); PG8_BAR; PG8_SCHED;
            PG8_STAGE(PG8_SB(0, 1), b2 + hstep);
            PG8_WAIT_V(6); PG8_BAR; PG8_MMA(1, 1, At, B1); PG8_BAR;
            PG8_LDB(B0, 1, 0); PG8_SCHED; PG8_LDA(At, 1, 0); PG8_STAGE(PG8_SA(0, 1), a2 + hstep);
            PG8_WAIT_L(8); PG8_BAR; PG8_WAIT_L(0); PG8_MMA(0, 0, At, B0); PG8_BAR; PG8_SCHED;
            PG8_LDB(B1, 1, 1); PG8_STAGE(PG8_SB(1, 0), b3);
            PG8_BAR; PG8_WAIT_L(0); PG8_MMA(0, 1, At, B1); PG8_BAR;
            PG8_LDA(At, 1, 1); PG8_STAGE(PG8_SA(1, 0), a3);
            PG8_BAR; PG8_WAIT_L(0); PG8_MMA(1, 0, At, B0); PG8_BAR; PG8_SCHED;
            PG8_STAGE(PG8_SB(1, 1), b3 + hstep);
            PG8_WAIT_V(6); PG8_BAR; PG8_MMA(1, 1, At, B1); PG8_BAR;
        }
        bool keep = false;
        if constexpr (Epi::PAIR) { if (cur.pm < 32) { E.mid(acc, cur, wr, wc, fr, fq); keep = true; } else E(acc, cur, wr, wc, fr, fq); }
        else E(acc, cur, wr, wc, fr, fq);
        if (!has_next) break;
        if (!keep)
#pragma unroll
        for (int a = 0; a < 2; ++a)
#pragma unroll
            for (int b = 0; b < 2; ++b)
#pragma unroll
                for (int m = 0; m < 4; ++m)
#pragma unroll
                    for (int n = 0; n < 2; ++n) acc[a][b][m][n] = (f32x4){0.f, 0.f, 0.f, 0.f};
        cur = nxt; cA = nA; cB = nB; ++ui;
    }
    PG8_WAIT_V(0);
    if (wr == 0) PG8_BAR;
    PG8_BAR;
#undef PG8_SA
#undef PG8_SB
#undef PG8_STAGE
#undef PG8_LDA
#undef PG8_LDB
#undef PG8_MMA
#undef PG8_WAIT_V
#undef PG8_WAIT_L
#undef PG8_BAR
#undef PG8_SCHED
}
}

typedef f32x4 AccT[2][2][4][2];

__device__ __forceinline__ void rs_table_fill(const Ctx cx, LAS unsigned char* lds, const pg8::StaticOrder& S, const float* ss) {
    LAS float* tab = (LAS float*)(lds + LDS_RST);
    const int t = cx.tid & 255, par = cx.tid >> 8;
    float sq[3]; bool ok[3];
#pragma unroll
    for (int k = 0; k < 3; ++k) {
        pg8::Unit u; ok[k] = S.next(2 * k + par, u); sq[k] = 0.f;
        if (ok[k]) { const float* sp = ss + (size_t)(u.pm * 256 + t) * 32;
#pragma unroll
            for (int j = 0; j < 8; ++j) { const f32x4 a = *(const f32x4*)(sp + 4 * j); sq[k] += (a[0] + a[1]) + (a[2] + a[3]); } }
    }
#pragma unroll
    for (int k = 0; k < 3; ++k) if (ok[k]) tab[(2 * k + par) * 256 + t] = rsqrtf(sq[k] * (1.0f / 2048.0f) + NORM_EPS);
    __syncthreads();
}
struct EpiInProj {
    static constexpr bool PAIR = false;
    const LAS float* rst; bf16_t* QB; bf16_t* KB; bf16_t* VT; float* PRW; bf16_t* SG;
    __device__ __forceinline__ void operator()(const AccT& acc, const pg8::Unit& u, int wr, int wc, int fr, int fq) const {
        const int row0 = u.pm * 256 + wr * 64 + fr, col0 = u.pn * 256 + wc * 32 + 4 * fq; const int pn = u.pn;
#pragma unroll
        for (int ai = 0; ai < 2; ++ai)
#pragma unroll
            for (int m = 0; m < 4; ++m) {
                const int row = row0 + ai * 128 + m * 16; const float rs = rst[u.idx * 256 + (row - u.pm * 256)];
#pragma unroll
                for (int bj = 0; bj < 2; ++bj) {
                    if (pn >= 20) {
                        const u32x2 a = pk4_bf16(sigm4(acc[ai][bj][m][0] * rs)), b = pk4_bf16(sigm4(acc[ai][bj][m][1] * rs));
                        u32x4 w; w.x = a.x; w.y = a.y; w.z = b.x; w.w = b.y;
                        *(u32x4*)(SG + tixa((size_t)row, (pn * 256 + bj * 128 + wc * 32 - 5120) + 8 * fq, 4096)) = w;
                    } else
#pragma unroll
                    for (int n = 0; n < 2; ++n) {
                        const int c = col0 + bj * 128 + n * 16; const f32x4 v = acc[ai][bj][m][n] * rs;
                        if (pn < 4) *(u32x2*)(QB + (size_t)row * 1024 + c) = pk4_bf16(v);
                        else if (pn == 4) { const int cc = c - 1024, kvh = cc >> 6, d = cc & 63, b = row >> 11, t = row & 2047;
                            *(u32x2*)(KB + ((size_t)((b * 4 + kvh) * 4 + (d >> 4)) * 2048 + t) * 16 + (d & 15)) = pk4_bf16(v); }
                        else if (pn == 5) { const int cc = c - 1280, kvh = cc >> 6, d = cc & 63, b = row >> 11, t = row & 2047; bf16_t* vp = VT + ((size_t)(b * 4 + kvh) * 512 + (t >> 2)) * 256 + d * 4 + (t & 3);
                            const u32x2 w = pk4_bf16(v); vp[0] = (bf16_t)(w.x & 0xffff); vp[4] = (bf16_t)(w.x >> 16); vp[8] = (bf16_t)(w.y & 0xffff); vp[12] = (bf16_t)(w.y >> 16); }
                        else *(f32x4*)(PRW + (prw_row(row) + prw_col(c - 1536))) = v;
                    }
                }
            }
    }
};
template <int SECOND> struct EpiBranch {
    static constexpr bool PAIR = false;
    const bf16_t* SG; float* MRGF; bf16_t* MRG;
    __device__ __forceinline__ void operator()(const AccT& acc, const pg8::Unit& u, int wr, int wc, int fr, int fq) const {
        const int row0 = u.pm * 256 + wr * 64 + fr, col0 = u.pn * 256 + wc * 32 + 4 * fq;
#pragma unroll
        for (int ai = 0; ai < 2; ++ai)
#pragma unroll
            for (int m = 0; m < 4; ++m) {
                const int row = row0 + ai * 128 + m * 16;
#pragma unroll
                for (int bj = 0; bj < 2; ++bj)
#pragma unroll
                    for (int n = 0; n < 2; ++n) {
                        const int c = col0 + bj * 128 + n * 16;
                        const f32x4 sg = unpk4_bf16(*(const u32x2*)(SG + (size_t)row * 4096 + SECOND * 2048 + c));
                        float* mp = MRGF + (size_t)row * 2048 + c;
                        if (!SECOND) *(f32x4*)mp = sg * acc[ai][bj][m][n];
                        else { const f32x4 o = *(const f32x4*)mp + sg * acc[ai][bj][m][n]; *(u32x2*)(MRG + (size_t)row * 2048 + c) = pk4_bf16(o); }
                    }
            }
    }
};
struct EpiBranchPair {
    static constexpr bool PAIR = true;
    const bf16_t* SG; bf16_t* MRG;
    __device__ __forceinline__ void mid(AccT& acc, const pg8::Unit& u, int wr, int wc, int fr, int fq) const {
        const int row0 = u.pm * 256 + wr * 64 + fr, col0 = u.pn * 256 + wc * 32 + 4 * fq;
#pragma unroll
        for (int ai = 0; ai < 2; ++ai)
#pragma unroll
            for (int m = 0; m < 4; ++m) {
                const int row = row0 + ai * 128 + m * 16;
#pragma unroll
                for (int bj = 0; bj < 2; ++bj) {
                    const int gc = (u.pn * 256 + bj * 128 + wc * 32) + 8 * fq;
                    const u32x4 sa8 = *(const u32x4*)(SG + tixa((size_t)row, gc, 4096)), sb8 = *(const u32x4*)(SG + tixa((size_t)row, 2048 + gc, 4096));
#pragma unroll
                    for (int n = 0; n < 2; ++n) {
                        const f32x4 sa = unpk4_bf16(n ? (u32x2){sa8.z, sa8.w} : (u32x2){sa8.x, sa8.y}), sb = unpk4_bf16(n ? (u32x2){sb8.z, sb8.w} : (u32x2){sb8.x, sb8.y});
                        f32x4 q; q[0] = sa[0] * __builtin_amdgcn_rcpf(sb[0]); q[1] = sa[1] * __builtin_amdgcn_rcpf(sb[1]); q[2] = sa[2] * __builtin_amdgcn_rcpf(sb[2]); q[3] = sa[3] * __builtin_amdgcn_rcpf(sb[3]);
                        acc[ai][bj][m][n] = acc[ai][bj][m][n] * q;
                    }
                }
            }
    }
    __device__ __forceinline__ void operator()(const AccT& acc, const pg8::Unit& u, int wr, int wc, int fr, int fq) const {
        const int row0 = (u.pm - 32) * 256 + wr * 64 + fr, col0 = (u.pn - 8) * 256 + wc * 32 + 4 * fq;
#pragma unroll
        for (int ai = 0; ai < 2; ++ai)
#pragma unroll
            for (int m = 0; m < 4; ++m) {
                const int row = row0 + ai * 128 + m * 16;
#pragma unroll
                for (int bj = 0; bj < 2; ++bj) {
                    const u32x4 sb8 = *(const u32x4*)(SG + tixa((size_t)row, 2048 + ((u.pn - 8) * 256 + bj * 128 + wc * 32) + 8 * fq, 4096));
                    const u32x2 m0 = pk4_bf16(acc[ai][bj][m][0] * unpk4_bf16((u32x2){sb8.x, sb8.y})), m1 = pk4_bf16(acc[ai][bj][m][1] * unpk4_bf16((u32x2){sb8.z, sb8.w}));
                    u32x4 w; w.x = m0.x; w.y = m0.y; w.z = m1.x; w.w = m1.y;
                    *(u32x4*)(MRG + tixa((size_t)row, ((u.pn - 8) * 256 + bj * 128 + wc * 32) + 8 * fq, 2048)) = w;
                }
            }
    }
};
struct EpiResid {
    static constexpr bool PAIR = false;
    const float* base; float* out; bf16_t* XB; float* ssn;
    __device__ __forceinline__ void operator()(const AccT& acc, const pg8::Unit& u, int wr, int wc, int fr, int fq) const {
        const int row0 = u.pm * 256 + wr * 64 + fr, col0 = u.pn * 256 + wc * 32 + 4 * fq;
#pragma unroll
        for (int ai = 0; ai < 2; ++ai)
#pragma unroll
            for (int m = 0; m < 4; ++m) {
                const int row = row0 + ai * 128 + m * 16; float s = 0.f;
#pragma unroll
                for (int bj = 0; bj < 2; ++bj) {
                    u32x4 w;
#pragma unroll
                    for (int n = 0; n < 2; ++n) {
                        const size_t o = (size_t)row * 2048 + col0 + bj * 128 + n * 16;
                        const f32x4 x = *(const f32x4*)(base + o) + acc[ai][bj][m][n];
                        *(f32x4*)(out + o) = x; s += dot4(x, x);
                        const u32x2 xb = pk4_bf16(x); if (n == 0) { w.x = xb.x; w.y = xb.y; } else { w.z = xb.x; w.w = xb.y; }
                    }
                    *(u32x4*)(XB + tixa((size_t)row, (u.pn * 256 + bj * 128 + wc * 32) + 8 * fq, 2048)) = w;
                }
                s += __shfl_xor(s, 16); s += __shfl_xor(s, 32);
                if (fq == 0) ssn[(size_t)row * 32 + u.pn * 4 + wc] = s;
            }
    }
};
struct EpiFFN {
    static constexpr bool PAIR = false;
    const LAS float* rst; bf16_t* ACT;
    __device__ __forceinline__ void operator()(const AccT& acc, const pg8::Unit& u, int wr, int wc, int fr, int fq) const {
        const int row0 = u.pm * 256 + wr * 64 + fr;
#pragma unroll
        for (int ai = 0; ai < 2; ++ai)
#pragma unroll
            for (int m = 0; m < 4; ++m) {
                const int row = row0 + ai * 128 + m * 16; const float rs = rst[u.idx * 256 + (row - u.pm * 256)];
                u32x4 w;
#pragma unroll
                for (int bj = 0; bj < 2; ++bj) {
                    const f32x4 g = acc[ai][bj][m][0] * rs, up = acc[ai][bj][m][1] * rs;
                    const u32x2 a = pk4_bf16(g * sigm4(g) * up);
                    if (bj == 0) { w.x = a.x; w.y = a.y; } else { w.z = a.x; w.w = a.y; }
                }
                *(u32x4*)(ACT + tixa((size_t)row, 128 * u.pn + 32 * wc + 8 * fq, FH_)) = w;
            }
    }
};

struct ConvD { const float* s0; const float* s1; const float* gain; bf16_t* dst; int ld0, ld1, inter, K, rt, k0, kperm; };
__device__ __forceinline__ ConvD conv_decode(const Params& p, int item) {
    ConvD d; d.s0 = nullptr; d.s1 = nullptr; d.gain = nullptr; d.ld0 = 0; d.ld1 = 0; d.inter = 0; d.kperm = 0;
    const int l = item / 7552; int it = item % 7552; int kt; size_t doff;
    if (it < 2304) {
        d.rt = it >> 4; kt = it & 15; d.K = 2048; d.kperm = 2; doff = OFF_WIN; d.gain = p.in[1] + l * 2048;
        const float* wl = p.in[4] + (size_t)l * D_ * NIN_;
#pragma unroll
        for (int s = 0; s < 2; ++s) {
            const int sg = 2 * d.rt + s; const float* ptr = nullptr; int ld = NIN_;
            if (sg < 153) ptr = wl + 32 * sg;
            else if (sg == 153) { if (l > 0) { ptr = p.in[17] + (size_t)(l - 1) * D_ * 32; ld = 32; } }
            else if (sg >= 160) ptr = wl + (32 * sg - 224);
            if (s == 0) { d.s0 = ptr; d.ld0 = ld; } else { d.s1 = ptr; d.ld1 = ld; }
        }
    } else if (it < 2560) { it -= 2304; d.rt = it >> 3; kt = it & 7; d.K = 1024; doff = OFF_WBA; d.s0 = p.in[21] + (size_t)l * C_ * D_ + 64 * d.rt; d.s1 = d.s0 + 32; d.ld0 = d.ld1 = D_; }
    else if (it < 2816) { it -= 2560; d.rt = it >> 3; kt = it & 7; d.K = 1024; doff = OFF_WBR; d.s0 = p.in[22] + (size_t)l * C_ * D_ + 64 * d.rt; d.s1 = d.s0 + 32; d.ld0 = d.ld1 = D_; }
    else if (it < 3328) { it -= 2816; d.rt = it >> 4; kt = it & 15; d.K = 2048; d.kperm = 2; doff = OFF_WO; d.s0 = p.in[23] + (size_t)l * D_ * D_ + 64 * d.rt; d.s1 = d.s0 + 32; d.ld0 = d.ld1 = D_; }
    else if (it < 6144) { it -= 3328; d.rt = it >> 4; kt = it & 15; d.K = 2048; d.kperm = 2; doff = OFF_WGU; d.s0 = p.in[24] + (size_t)l * D_ * FH_ + 32 * d.rt; d.s1 = p.in[25] + (size_t)l * D_ * FH_ + 32 * d.rt; d.ld0 = d.ld1 = FH_; d.inter = 1; d.gain = p.in[2] + l * 2048; }
    else { it -= 6144; d.rt = it / 44; kt = it % 44; d.K = 5632; d.kperm = 1; doff = OFF_WD; d.s0 = p.in[26] + (size_t)l * FH_ * D_ + 64 * d.rt; d.s1 = d.s0 + 32; d.ld0 = d.ld1 = D_; }
    d.dst = (bf16_t*)(p.ws + WS_W) + (size_t)l * LSTRIDE + doff; d.k0 = kt * 128;
    return d;
}
__device__ __forceinline__ void conv_load(const ConvD& d, int tid, f32x4 (&v)[4], float (&g)[4]) {
#pragma unroll
    for (int i = 0; i < 4; ++i) {
        const int idx = tid + 512 * i, seg = idx >> 10, rem = idx & 1023, krow = rem >> 3, c4 = rem & 7;
        const float* ptr = seg ? d.s1 : d.s0; const int ld = seg ? d.ld1 : d.ld0;
        v[i] = (f32x4){0.f, 0.f, 0.f, 0.f}; g[i] = 1.0f;
        if (ptr) v[i] = *(const f32x4*)(ptr + (size_t)(d.k0 + krow) * ld + 4 * c4);
        if (d.gain) g[i] = d.gain[d.k0 + krow];
    }
}
__device__ __forceinline__ void conv_store(const ConvD& d, int tid, LAS bf16_t* tile, const f32x4 (&v)[4], const float (&g)[4]) {
#pragma unroll
    for (int i = 0; i < 4; ++i) {
        const int idx = tid + 512 * i, seg = idx >> 10, rem = idx & 1023, krow = rem >> 3, c4 = rem & 7;
        const u32x2 w = pk4_bf16(v[i] * g[i]);
        const int cc = 4 * c4;
        const int r = d.inter ? (32 * (cc >> 4) + 16 * seg + (cc & 15)) : (32 * seg + cc);
        const int kc = d.kperm == 1 ? (32 * ((krow >> 4) & 3) + 8 * ((krow >> 2) & 3) + 4 * (krow >> 6) + (krow & 3))
                     : d.kperm == 2 ? ((krow & ~31) + 8 * ((krow >> 2) & 3) + 4 * ((krow >> 4) & 1) + (krow & 3)) : krow;
        tile[(r + 0) * 136 + kc] = (bf16_t)(w.x & 0xffff); tile[(r + 1) * 136 + kc] = (bf16_t)(w.x >> 16);
        tile[(r + 2) * 136 + kc] = (bf16_t)(w.y & 0xffff); tile[(r + 3) * 136 + kc] = (bf16_t)(w.y >> 16);
    }
    __syncthreads();
#pragma unroll
    for (int i = 0; i < 2; ++i) {
        const int id = tid + 512 * i, blk = id >> 6, within = id & 63, r = 16 * (blk >> 2) + (within >> 2), k = 32 * (blk & 3) + 8 * (within & 3);
        const u32x4 w = *(const LAS u32x4*)(tile + r * 136 + k);
        *(u32x4*)(d.dst + tixa((size_t)(64 * d.rt + r), d.k0 + k, d.K)) = w;
    }
}
constexpr int CV_SLOT = 22, CV_Q = CV_SLOT * 128, CV_REM = 7552 - 2 * CV_Q, CV_P0 = 7552 + 3 * CV_REM;
__device__ __forceinline__ int conv_map(int j, bool p0map) {
    if (!p0map || j < 7552) return j;
    const int jj = j - 7552, L = 1 + jj / CV_REM; return L * 7552 + 2 * CV_Q + jj % CV_REM;
}
__device__ __forceinline__ void conv_run(const Ctx cx, const Params& p, LAS unsigned char* lds, int first, int n, int stride, bool p0map) {
    if (n <= 0) return;
    const int tid = cx.tid;
    f32x4 v[4], nv[4]; float g[4], ng[4];
    ConvD d = conv_decode(p, conv_map(first, p0map));
    conv_load(d, tid, v, g);
    __syncthreads();
#pragma unroll 1
    for (int i = 0; i < n; ++i) {
        ConvD dn = d;
        if (i + 1 < n) { dn = conv_decode(p, conv_map(first + (i + 1) * stride, p0map)); conv_load(dn, tid, nv, ng); }
        conv_store(d, tid, (LAS bf16_t*)lds + (i & 1) * (64 * 136), v, g);
        d = dn;
#pragma unroll
        for (int j = 0; j < 4; ++j) { v[j] = nv[j]; g[j] = ng[j]; }
    }
    __syncthreads();
}
__device__ __forceinline__ void p0_prologue(const Ctx cx, const Params& p, LAS unsigned char* lds) {
    const int tid = cx.tid, G = cx.G, bx = cx.bx, wave = tid >> 6, lane = tid & 63;
    float* SS = (float*)(p.ws + WS_SS);
    {
        const float* x = p.in[0]; bf16_t* XB = (bf16_t*)(p.ws + WS_XB);
        int row = bx * 8 + wave; f32x4 nx[8];
        if (row < M_) {
#pragma unroll
            for (int i = 0; i < 8; ++i) nx[i] = ((const f32x4*)(x + (size_t)row * D_))[lane + 64 * i];
        }
#pragma unroll 1
        for (; row < M_; row += G * 8) {
            f32x4 v[8];
#pragma unroll
            for (int i = 0; i < 8; ++i) v[i] = nx[i];
            if (row + G * 8 < M_) {
#pragma unroll
                for (int i = 0; i < 8; ++i) nx[i] = ((const f32x4*)(x + (size_t)(row + G * 8) * D_))[lane + 64 * i];
            }
            float s = 0.f;
#pragma unroll
            for (int i = 0; i < 8; ++i) { s += dot4(v[i], v[i]);
                const int lc = (lane + 64 * i) * 4, pc = (lc & ~31) + 8 * ((lc >> 2) & 3) + 4 * ((lc >> 4) & 1);
                *(u32x2*)(XB + tixa((size_t)row, pc, D_)) = pk4_bf16(v[i]); }
#pragma unroll
            for (int o = 32; o >= 1; o >>= 1) s += __shfl_xor(s, o);
            if (lane < 32) SS[(size_t)row * 32 + lane] = (lane == 0) ? s : 0.f;
        }
    }
    {
        bf16_t* UPS = (bf16_t*)(p.ws + WS_UPS);
        for (int i = bx * 512 + tid; i < 4 * UPS_L; i += G * 512) {
            const int l = i / UPS_L, r = i % UPS_L, kk_ = r >> 10, ch = r & 1023; float v; int dst;
            if (kk_ < 64) { const int k = kk_; v = p.in[7][((size_t)l * 64 + k) * C_ + ch]; dst = UPS_D + ((ch >> 4) * 2 + (k >> 5)) * 512 + (ch & 15) * 32 + (k & 31); }
            else if (kk_ < 128) { const int k = kk_ - 64; v = p.in[9][((size_t)l * 64 + k) * C_ + ch]; dst = UPS_I + ((ch >> 4) * 2 + (k >> 5)) * 512 + (ch & 15) * 32 + (k & 31); }
            else if (kk_ < 288) { const int k = kk_ - 128; v = p.in[11][((size_t)l * 160 + k) * C_ + ch]; dst = UPS_G + ((ch >> 4) * 5 + (k >> 5)) * 512 + (ch & 15) * 32 + (k & 31); }
            else { const int k = kk_ - 288; v = l > 0 ? p.in[19][((size_t)(l - 1) * 32 + k) * C_ + ch] : 0.f; dst = UPS_V + (ch >> 4) * 512 + (ch & 15) * 32 + k; }
            UPS[(size_t)l * UPS_L + dst] = (bf16_t)(pk_bf16(v, 0.f) & 0xffff);
        }
    }
    if (G == 256) conv_run(cx, p, lds, bx, (CV_P0 - bx + G - 1) / G, G, true);
    else conv_run(cx, p, lds, bx, (4 * 7552 - bx + G - 1) / G, G, false);
}

#define MFMA16(a, b, c) __builtin_amdgcn_mfma_f32_16x16x32_bf16((a), (b), (c), 0, 0, 0)
#define MFMA32(a, b, c) __builtin_amdgcn_mfma_f32_32x32x16_bf16((a), (b), (c), 0, 0, 0)

__device__ __forceinline__ void prep_phase(const Ctx cx, const Params& p, LAS unsigned char* lds, int l) {
    const int tid = cx.tid, wave = tid >> 6, lane = tid & 63, G = cx.G, tl = lane & 15, kq = lane >> 4;
    const float* PRW = (const float*)(p.ws + WS_PRW);
    float* SC = (float*)(p.ws + WS_SCAN);
    float* Wo = SC; bf16_t* SB = (bf16_t*)(SC + ARR); bf16_t* KKo = SB, *BBo = SB + ARR, *KMo = SB + 2 * ARR, *Ro = SB + 3 * ARR, *Vo = SB + 4 * ARR;
    float* VF = (float*)(p.ws + WS_VFIRST); bf16_t* Gb = (bf16_t*)(p.ws + WS_G);
    const bf16_t* UPS = (const bf16_t*)(p.ws + WS_UPS) + (size_t)l * UPS_L;
    const float* tsm = p.in[6] + (size_t)l * 3360;
    const float* vmix = p.in[18] + (size_t)(l > 0 ? l - 1 : 0) * 32;
    const float* dbias = p.in[8] + l * C_; const float* ibias = p.in[10] + l * C_; const float* kkp = p.in[12] + l * C_; const float* kap = p.in[13] + l * C_;
    const float* vbias = p.in[20] + (size_t)(l > 0 ? l - 1 : 0) * C_;
    LAS u32x4* fr = (LAS u32x4*)lds + wave * 640 + lane;
#pragma unroll 1
    for (int task = cx.bx * 8 + wave; task < 2048; task += G * 8) {
        const int tile = task >> 2, quarter = task & 3;
        const int row = tile * 16 + tl; const bool hasprev = (row & 2047) != 0;
        const unsigned po = prw_row(row), ppo = hasprev ? prw_row(row - 1) : po; const float pm = hasprev ? 1.0f : 0.0f;
#pragma unroll 5
        for (int s = 0; s < 10; ++s) {
            u32x4 w = {0u, 0u, 0u, 0u};
            if (s < 9 || l > 0) {
                const int col = 3072 + 32 * s + 8 * kq;
                f32x4 c0 = *(const f32x4*)(PRW + (po + prw_col(col))), c1 = *(const f32x4*)(PRW + (po + prw_col(col + 4)));
                const f32x4 q0 = *(const f32x4*)(PRW + (ppo + prw_col(col))) * pm, q1 = *(const f32x4*)(PRW + (ppo + prw_col(col + 4))) * pm;
                const float* mup = (s < 9) ? (tsm + col) : (vmix + 8 * kq);
                const f32x4 m0 = *(const f32x4*)mup, m1 = *(const f32x4*)(mup + 4);
                c0 = c0 + (q0 - c0) * m0; c1 = c1 + (q1 - c1) * m1;
                if (s < 2) {
#pragma unroll
                    for (int e = 0; e < 4; ++e) { c0[e] = tanh_fast(c0[e]); c1[e] = tanh_fast(c1[e]); }
                } else if (s >= 4 && s < 9) { c0 = sigm4(c0); c1 = sigm4(c1); }
                const u32x2 a = pk4_bf16(c0), b = pk4_bf16(c1); w.x = a.x; w.y = a.y; w.z = b.x; w.w = b.y;
            }
            fr[s * 64] = w;
        }
#pragma unroll 1
        for (int hh = 0; hh < 4; ++hh) {
            const int cb = quarter * 256 + hh * 64;
            float ssq = 0.f;
#pragma unroll
            for (int ct = 0; ct < 4; ++ct) {
                const int c = cb + 16 * ct + 4 * kq;
                f32x4 k = *(const f32x4*)(PRW + (po + prw_col(1024 + c))); const f32x4 kp = *(const f32x4*)(PRW + (ppo + prw_col(1024 + c))) * pm;
                k = k + (kp - k) * *(const f32x4*)(tsm + 1024 + c);
                const f32x4 kk = k * *(const f32x4*)(kkp + c); ssq += dot4(kk, kk);
            }
            ssq += __shfl_xor(ssq, 16); ssq += __shfl_xor(ssq, 32);
            const float inv = 1.0f / fmaxf(sqrtf(ssq), 1e-12f);
            f32x4 xr, xk, xv, xrp, xkp, xvp, xdb, xib, xkk, xka, xvb, xvf, xmr, xmk, xmv; bf16x8 xu[10];
#define PREP_LOAD(ct_) do { const int c_ = cb + 16 * (ct_) + 4 * kq; \
                xr = *(const f32x4*)(PRW + (po + prw_col(c_))); xk = *(const f32x4*)(PRW + (po + prw_col(1024 + c_))); xv = *(const f32x4*)(PRW + (po + prw_col(2048 + c_))); \
                xrp = *(const f32x4*)(PRW + (ppo + prw_col(c_))); xkp = *(const f32x4*)(PRW + (ppo + prw_col(1024 + c_))); xvp = *(const f32x4*)(PRW + (ppo + prw_col(2048 + c_))); \
                xdb = *(const f32x4*)(dbias + c_); xib = *(const f32x4*)(ibias + c_); xkk = *(const f32x4*)(kkp + c_); xka = *(const f32x4*)(kap + c_); \
                xvb = *(const f32x4*)(vbias + c_); xvf = (l > 0) ? *(const f32x4*)(VF + tix(row, c_)) : (f32x4){0.f, 0.f, 0.f, 0.f}; \
                xmr = *(const f32x4*)(tsm + c_); xmk = *(const f32x4*)(tsm + 1024 + c_); xmv = *(const f32x4*)(tsm + 2048 + c_); } while (0)
#define PREP_LOADU(ct_) do { const int t16_ = (cb >> 4) + (ct_); const bf16_t* ub_ = UPS + tl * 32 + 8 * kq; \
                  _Pragma("unroll") for (int s_ = 0; s_ < 2; ++s_) { xu[s_] = *(const bf16x8*)(ub_ + UPS_D + (t16_ * 2 + s_) * 512); xu[2 + s_] = *(const bf16x8*)(ub_ + UPS_I + (t16_ * 2 + s_) * 512); } \
                  _Pragma("unroll") for (int s_ = 0; s_ < 5; ++s_) xu[4 + s_] = *(const bf16x8*)(ub_ + UPS_G + (t16_ * 5 + s_) * 512); \
                  xu[9] = *(const bf16x8*)(ub_ + UPS_V + t16_ * 512); } while (0)
            PREP_LOAD(0); PREP_LOADU(0);
#pragma unroll 1
            for (int ct = 0; ct < 4; ++ct) {
                const int ch0 = cb + 16 * ct;
                f32x4 aw = {0.f, 0.f, 0.f, 0.f}, aa = aw, ag = aw, avv = aw;
#pragma unroll
                for (int s = 0; s < 2; ++s) aw = MFMA16(xu[s], __builtin_bit_cast(bf16x8, fr[s * 64]), aw);
#pragma unroll
                for (int s = 0; s < 2; ++s) aa = MFMA16(xu[2 + s], __builtin_bit_cast(bf16x8, fr[(2 + s) * 64]), aa);
#pragma unroll
                for (int s = 0; s < 5; ++s) ag = MFMA16(xu[4 + s], __builtin_bit_cast(bf16x8, fr[(4 + s) * 64]), ag);
                if (l > 0) avv = MFMA16(xu[9], __builtin_bit_cast(bf16x8, fr[9 * 64]), avv);
                asm volatile("" ::: "memory"); if (ct < 3) PREP_LOADU(ct + 1);
                const int c = ch0 + 4 * kq; const unsigned o = tix(row, c);
                const f32x4 r = xr + (xrp * pm - xr) * xmr, k = xk + (xkp * pm - xk) * xmk; f32x4 v = xv + (xvp * pm - xv) * xmv;
                *(u32x2*)(Ro + o) = pk4_bf16(r);
                const f32x4 sg = sigm4(xdb + aw);
                f32x4 dec;
#pragma unroll
                for (int e = 0; e < 4; ++e) dec[e] = __expf(-0.6065306597126334f * sg[e]);
                *(f32x4*)(Wo + o) = dec;
                const f32x4 a = sigm4(xib + aa);
                if (l > 0) v = v + (xvf - v) * sigm4(xvb + avv);
                else *(f32x4*)(VF + o) = v;
                *(u32x2*)(Vo + o) = pk4_bf16(v);
                const f32x4 kk = k * xkk * inv;
                *(u32x2*)(KKo + o) = pk4_bf16(kk); *(u32x2*)(BBo + o) = pk4_bf16(kk * a);
                const f32x4 km = k * (1.0f + (a - 1.0f) * xka);
                *(u32x2*)(KMo + o) = pk4_bf16(km);
                *(u32x2*)(Gb + o) = pk4_bf16(ag);
                asm volatile("" ::: "memory"); if (ct < 3) PREP_LOAD(ct + 1);
            }
#undef PREP_LOADU
#undef PREP_LOAD
        }
    }
}

__device__ __forceinline__ bf16x8 pack8(const f32x16& x, const int s) {
    u32x4 w; w.x = pk_bf16(x[8 * s], x[8 * s + 1]); w.y = pk_bf16(x[8 * s + 2], x[8 * s + 3]); w.z = pk_bf16(x[8 * s + 4], x[8 * s + 5]); w.w = pk_bf16(x[8 * s + 6], x[8 * s + 7]);
    return __builtin_bit_cast(bf16x8, w);
}
__device__ __forceinline__ void attn_task(const Params& p, int l, int task, int lane) {
    const bf16_t* QB = (const bf16_t*)(p.ws + WS_QB); const bf16_t* KB = (const bf16_t*)(p.ws + WS_KB); const bf16_t* VT = (const bf16_t*)(p.ws + WS_VT); bf16_t* YA = (bf16_t*)(p.ws + WS_YA);
    const int qt = task & 63, head = (task >> 6) & 15, b = task >> 10;
    const int c = lane & 31, h = lane >> 5, kvh = head >> 2;
    const float slope = exp2f(-0.5f * (float)(head + 1)); const float sink = p.in[5][l * 16 + head];
    const int q0 = qt * 32; const size_t rb = (size_t)b * T_;
    bf16x8 qf[4];
#pragma unroll
    for (int dd = 0; dd < 4; ++dd) qf[dd] = *(const bf16x8*)(QB + (rb + q0 + c) * 1024 + head * 64 + 16 * dd + 8 * h);
    f32x16 S[5];
#pragma unroll
    for (int kt = 0; kt < 5; ++kt) {
        const int key = q0 - 128 + 32 * kt + c, keyc = key < 0 ? 0 : key;
        f32x16 acc;
#pragma unroll
        for (int e = 0; e < 16; ++e) acc[e] = 0.f;
#pragma unroll
        for (int dd = 0; dd < 4; ++dd) acc = MFMA32(*(const bf16x8*)(KB + ((size_t)((b * 4 + kvh) * 4 + dd) * 2048 + keyc) * 16 + 8 * h), qf[dd], acc);
        S[kt] = acc;
    }
    const int t = q0 + c; float mx = sink;
#pragma unroll
    for (int kt = 0; kt < 5; ++kt)
#pragma unroll
        for (int e = 0; e < 16; ++e) {
            const int s = q0 - 128 + 32 * kt + (e & 3) + 8 * (e >> 2) + 4 * h, dist = t - s;
            const bool valid = (dist >= 0) && (dist < 128) && (s >= 0);
            const float val = valid ? (S[kt][e] * 0.125f - slope * (float)dist) : -INFINITY;
            S[kt][e] = val; mx = fmaxf(mx, val);
        }
    mx = fmaxf(mx, __shfl_xor(mx, 32));
    float sum = 0.f;
#pragma unroll
    for (int kt = 0; kt < 5; ++kt)
#pragma unroll
        for (int e = 0; e < 16; ++e) { const float pv = __expf(S[kt][e] - mx); S[kt][e] = pv; sum += pv; }
    sum += __shfl_xor(sum, 32);
    const float inv = 1.0f / (sum + __expf(sink - mx));
    f32x16 O[2];
#pragma unroll
    for (int e = 0; e < 16; ++e) { O[0][e] = 0.f; O[1][e] = 0.f; }
#pragma unroll
    for (int kt = 0; kt < 5; ++kt)
#pragma unroll
        for (int s = 0; s < 2; ++s) {
            const bf16x8 pf = pack8(S[kt], s);
            const int kb = q0 - 128 + 32 * kt + 16 * s + 4 * h; const int k_lo = kb < 0 ? 0 : kb, k_hi = kb + 8 < 0 ? 0 : kb + 8;
#pragma unroll
            for (int dt = 0; dt < 2; ++dt) {
                const bf16_t* vb = VT + (size_t)(b * 4 + kvh) * (512 * 256) + (32 * dt + c) * 4;
                const u32x2 lo = *(const u32x2*)(vb + (k_lo >> 2) * 256), hi = *(const u32x2*)(vb + (k_hi >> 2) * 256);
                u32x4 w; w.x = lo.x; w.y = lo.y; w.z = hi.x; w.w = hi.y;
                O[dt] = MFMA32(__builtin_bit_cast(bf16x8, w), pf, O[dt]);
            }
        }
#pragma unroll
    for (int dt = 0; dt < 2; ++dt)
#pragma unroll
        for (int g4 = 0; g4 < 4; ++g4) {
            const int d = 32 * dt + 8 * g4 + 4 * h;
            f32x4 v = {O[dt][4 * g4] * inv, O[dt][4 * g4 + 1] * inv, O[dt][4 * g4 + 2] * inv, O[dt][4 * g4 + 3] * inv};
            *(u32x2*)(YA + tixa(rb + q0 + c, head * 64 + d, 1024)) = pk4_bf16(v);
        }
}
__device__ __forceinline__ void attn_phase(const Ctx cx, const Params& p, int l) {
    const int wave = cx.tid >> 6, lane = cx.tid & 63;
    for (int task = cx.bx * 8 + wave; task < 4096; task += cx.G * 8) attn_task(p, l, task, lane);
}

struct AttnT { int b, head, kvh, q0, c, h; float slope, sink; size_t rb; };
__device__ __forceinline__ void at_decode(AttnT& t, const Params& p, int l, int task, int lane) {
    const int qt = task & 63; t.head = (task >> 6) & 15; t.b = task >> 10; t.c = lane & 31; t.h = lane >> 5; t.kvh = t.head >> 2;
    t.slope = exp2f(-0.5f * (float)(t.head + 1)); t.sink = p.in[5][l * 16 + t.head]; t.q0 = qt * 32; t.rb = (size_t)t.b * T_;
}
__device__ __forceinline__ void at_load_q(const Params& p, const AttnT& t, bf16x8 (&qf)[4]) {
    const bf16_t* QB = (const bf16_t*)(p.ws + WS_QB);
#pragma unroll
    for (int dd = 0; dd < 4; ++dd) qf[dd] = *(const bf16x8*)(QB + (t.rb + t.q0 + t.c) * 1024 + t.head * 64 + 16 * dd + 8 * t.h);
}
template <int BASE> __device__ __forceinline__ void at_load_k(const Params& p, const AttnT& t, int kt, u32x4 (&buf)[4]) {
    const bf16_t* KB = (const bf16_t*)(p.ws + WS_KB);
    const int key = t.q0 - 128 + 32 * kt + t.c, keyc = key < 0 ? 0 : key;
#pragma unroll
    for (int dd = 0; dd < 4; ++dd) buf[BASE + dd] = *(const u32x4*)(KB + ((size_t)((t.b * 4 + t.kvh) * 4 + dd) * 2048 + keyc) * 16 + 8 * t.h);
}
template <int BASE> __device__ __forceinline__ void at_qk(const bf16x8 (&qf)[4], const u32x4 (&buf)[4], f32x16& S) {
    f32x16 acc;
#pragma unroll
    for (int e = 0; e < 16; ++e) acc[e] = 0.f;
#pragma unroll
    for (int dd = 0; dd < 4; ++dd) acc = MFMA32(__builtin_bit_cast(bf16x8, buf[BASE + dd]), qf[dd], acc);
    S = acc;
}
__device__ __forceinline__ float at_softmax_a(const AttnT& t, f32x16 (&S)[5]) {
    const int tq = t.q0 + t.c; float mx = t.sink;
#pragma unroll
    for (int kt = 0; kt < 5; ++kt)
#pragma unroll
        for (int e = 0; e < 16; ++e) {
            const int s = t.q0 - 128 + 32 * kt + (e & 3) + 8 * (e >> 2) + 4 * t.h, dist = tq - s;
            const bool valid = (dist >= 0) && (dist < 128) && (s >= 0);
            const float val = valid ? (S[kt][e] * 0.125f - t.slope * (float)dist) : -INFINITY;
            S[kt][e] = val; mx = fmaxf(mx, val);
        }
    return fmaxf(mx, __shfl_xor(mx, 32));
}
__device__ __forceinline__ float at_softmax_b(const AttnT& t, f32x16 (&S)[5], float mx) {
    float sum = 0.f;
#pragma unroll
    for (int kt = 0; kt < 5; ++kt)
#pragma unroll
        for (int e = 0; e < 16; ++e) { const float pv = __expf(S[kt][e] - mx); S[kt][e] = pv; sum += pv; }
    sum += __shfl_xor(sum, 32);
    return 1.0f / (sum + __expf(t.sink - mx));
}
template <int BASE> __device__ __forceinline__ void at_load_v(const Params& p, const AttnT& t, int kt, u32x4 (&buf)[4]) {
    const bf16_t* VT = (const bf16_t*)(p.ws + WS_VT);
#pragma unroll
    for (int s = 0; s < 2; ++s) {
        const int kb = t.q0 - 128 + 32 * kt + 16 * s + 4 * t.h; const int k_lo = kb < 0 ? 0 : kb, k_hi = kb + 8 < 0 ? 0 : kb + 8;
#pragma unroll
        for (int dt = 0; dt < 2; ++dt) {
            const bf16_t* vb = VT + (size_t)(t.b * 4 + t.kvh) * (512 * 256) + (32 * dt + t.c) * 4;
            const u32x2 lo = *(const u32x2*)(vb + (k_lo >> 2) * 256), hi = *(const u32x2*)(vb + (k_hi >> 2) * 256);
            u32x4 w; w.x = lo.x; w.y = lo.y; w.z = hi.x; w.w = hi.y; buf[BASE + 2 * s + dt] = w;
        }
    }
}
template <int BASE> __device__ __forceinline__ void at_pv(const f32x16& Skt, const u32x4 (&buf)[4], f32x16 (&O)[2]) {
#pragma unroll
    for (int s = 0; s < 2; ++s) {
        const bf16x8 pf = pack8(Skt, s);
#pragma unroll
        for (int dt = 0; dt < 2; ++dt) O[dt] = MFMA32(__builtin_bit_cast(bf16x8, buf[BASE + 2 * s + dt]), pf, O[dt]);
    }
}
__device__ __forceinline__ void at_store(const Params& p, const AttnT& t, const f32x16 (&O)[2], float inv) {
    bf16_t* YA = (bf16_t*)(p.ws + WS_YA);
#pragma unroll
    for (int dt = 0; dt < 2; ++dt)
#pragma unroll
        for (int g4 = 0; g4 < 4; ++g4) {
            const int d = 32 * dt + 8 * g4 + 4 * t.h;
            f32x4 v = {O[dt][4 * g4] * inv, O[dt][4 * g4 + 1] * inv, O[dt][4 * g4 + 2] * inv, O[dt][4 * g4 + 3] * inv};
            *(u32x2*)(YA + tixa(t.rb + t.q0 + t.c, t.head * 64 + d, 1024)) = pk4_bf16(v);
        }
}

constexpr int SC_CH = 32, SC_STEP = 336;
__device__ __forceinline__ void scan_phase(const Ctx cx, const Params& p, LAS unsigned char* lds, int l, bool fuse_attn) {
    const int tid = cx.tid, wave = __builtin_amdgcn_readfirstlane(tid >> 6), lane = tid & 63, G = cx.G;
    const float* SC = (const float*)(p.ws + WS_SCAN); float* YRAW = (float*)(p.ws + WS_PRW);
    LAS float* ring = (LAS float*)lds;
    for (int tb = cx.bx; tb < 256; tb += G) {
        const int bh = tb >> 2, q = tb & 3, b = bh >> 4, hd = bh & 15;
        const size_t rowb = (size_t)b * T_; const int cbase = hd * 64;
        __syncthreads();
        if (tid >= 256) {
            int ht = tid - 256; asm volatile("" : "+v"(ht));
            const bf16_t* SBh = (const bf16_t*)(SC + ARR);
            const unsigned gw0 = tix((int)rowb + (ht >> 4), cbase + 4 * (ht & 15)), lw0 = (unsigned)((ht >> 4) * SC_STEP + 64 + 4 * (ht & 15));
            const unsigned gb0 = tix((int)rowb + (ht >> 3), cbase + 8 * (ht & 7)), lb0 = (unsigned)((ht >> 3) * SC_STEP + 8 * (ht & 7));
            unsigned gv, lv;
#define gw(i) (gw0 + (unsigned)(i) * 16384u)
#define lw(i) (lw0 + (unsigned)(i) * (16u * SC_STEP))
#define gb(i) (gb0 + (unsigned)(i) * (unsigned)ARR)
#define lb(i) (lb0 + ((i) == 0 ? 0u : 64u + 64u * (unsigned)(i)))
            { const int j = ht & 63, step = j >> 1, c8 = j & 1; gv = 4u * (unsigned)ARR + tix((int)rowb + step, cbase + 16 * q + 8 * c8); lv = (unsigned)(step * SC_STEP + 320 + 8 * c8); }
            const bool hasv = ht < 64;
            f32x4 tw[2]; u32x4 tb[4], tv = {0u, 0u, 0u, 0u};
#define SCAN_LOAD(cofs_) do { _Pragma("unroll") for (int i = 0; i < 2; ++i) tw[i] = *(const f32x4*)(SC + (size_t)(gw(i) + (cofs_))); \
                _Pragma("unroll") for (int i = 0; i < 4; ++i) tb[i] = *(const u32x4*)(SBh + (size_t)(gb(i) + (cofs_))); \
                if (hasv) tv = *(const u32x4*)(SBh + (size_t)(gv + (cofs_))); } while (0)
#define SCAN_PUT8(dst_, w_) do { f32x4 lo_, hi_; lo_[0] = __uint_as_float((w_).x << 16); lo_[1] = __uint_as_float((w_).x & 0xffff0000u); lo_[2] = __uint_as_float((w_).y << 16); lo_[3] = __uint_as_float((w_).y & 0xffff0000u); \
                hi_[0] = __uint_as_float((w_).z << 16); hi_[1] = __uint_as_float((w_).z & 0xffff0000u); hi_[2] = __uint_as_float((w_).w << 16); hi_[3] = __uint_as_float((w_).w & 0xffff0000u); \
                *(LAS f32x4*)(dst_) = lo_; *(LAS f32x4*)((dst_) + 4) = hi_; } while (0)
#define SCAN_STORE(buf_) do { _Pragma("unroll") for (int i = 0; i < 2; ++i) *(LAS f32x4*)((buf_) + lw(i)) = tw[i]; \
                _Pragma("unroll") for (int i = 0; i < 4; ++i) SCAN_PUT8((buf_) + lb(i), tb[i]); \
                if (hasv) SCAN_PUT8((buf_) + lv, tv); } while (0)
            SCAN_LOAD(0u);
            SCAN_STORE(ring);
            SCAN_LOAD((unsigned)SC_CH * C_);
            __syncthreads();
#define SCAN_HB(c_) do { const int cc_ = (c_); if (cc_ < T_ / SC_CH) { LAS float* hb_ = ring + (cc_ & 1) * SC_CH * SC_STEP; SCAN_STORE(hb_); \
                if (cc_ + 1 < T_ / SC_CH) { const unsigned cofs_ = (unsigned)(cc_ + 1) * SC_CH * C_; SCAN_LOAD(cofs_); } } __syncthreads(); } while (0)
            const int hwid = cx.bx * 4 + (wave - 4);
            const bool act = fuse_attn;
#pragma unroll 1
            for (int grp = 0; grp < 4; ++grp) {
                const int cb = 1 + grp * 16;
                AttnT at; bf16x8 qf[4]; u32x4 ab[4]; f32x16 S[5]; f32x16 O[2]; float inv = 0.f, mx = 0.f;
                int task_ = grp * 1024 + hwid; asm volatile("" : "+s"(task_));
                int ln_ = lane; asm volatile("" : "+v"(ln_));
                if (act) { at_decode(at, p, l, task_, ln_); at_load_q(p, at, qf); at_load_k<0>(p, at, 0, ab); }
                SCAN_HB(cb + 0);
                if (act) { at_qk<0>(qf, ab, S[0]); at_load_k<0>(p, at, 1, ab); }
                SCAN_HB(cb + 1);
                if (act) { at_qk<0>(qf, ab, S[1]); at_load_k<0>(p, at, 2, ab); }
                SCAN_HB(cb + 2);
                if (act) { at_qk<0>(qf, ab, S[2]); at_load_k<0>(p, at, 3, ab); }
                SCAN_HB(cb + 3);
                if (act) { at_qk<0>(qf, ab, S[3]); at_load_k<0>(p, at, 4, ab); }
                SCAN_HB(cb + 4);
                if (act) { at_qk<0>(qf, ab, S[4]); }
                SCAN_HB(cb + 5);
                if (act) { mx = at_softmax_a(at, S); }
                SCAN_HB(cb + 6);
                if (act) { inv = at_softmax_b(at, S, mx); at_load_v<0>(p, at, 0, ab); }
                SCAN_HB(cb + 7);
                if (act) {
#pragma unroll
                    for (int e = 0; e < 16; ++e) { O[0][e] = 0.f; O[1][e] = 0.f; }
                    at_pv<0>(S[0], ab, O); at_load_v<0>(p, at, 1, ab); }
                SCAN_HB(cb + 8);
                if (act) { at_pv<0>(S[1], ab, O); at_load_v<0>(p, at, 2, ab); }
                SCAN_HB(cb + 9);
                if (act) { at_pv<0>(S[2], ab, O); at_load_v<0>(p, at, 3, ab); }
                SCAN_HB(cb + 10);
                if (act) { at_pv<0>(S[3], ab, O); at_load_v<0>(p, at, 4, ab); }
                SCAN_HB(cb + 11);
                if (act) { at_pv<0>(S[4], ab, O); at_store(p, at, O, inv); }
                SCAN_HB(cb + 12);
                SCAN_HB(cb + 13);
                SCAN_HB(cb + 14);
                SCAN_HB(cb + 15);
            }
#undef SCAN_HB
#undef gw
#undef lw
#undef gb
#undef lb
#undef SCAN_LOAD
#undef SCAN_PUT8
#undef SCAN_STORE
        } else {
            int lane_s = lane; asm volatile("" : "+v"(lane_s));
            const int jg = lane_s & 15, ri = lane_s >> 4;
            f32x2 Sa = {0.f, 0.f}, Sb = {0.f, 0.f};
            __builtin_amdgcn_s_setprio(3);
            __syncthreads();
            for (int c = 0; c < T_ / SC_CH; ++c) {
                const LAS float* base = ring + (c & 1) * SC_CH * SC_STEP;
                float* yp = YRAW + tix((int)rowb + c * SC_CH + jg, cbase + 16 * q + 4 * wave + ri);
                const LAS float* lp = base + 4 * jg; const LAS float* vp = base + 320 + 4 * wave + ri;
                f32x4 kk = *(const LAS f32x4*)(lp), w = *(const LAS f32x4*)(lp + 64), bb = *(const LAS f32x4*)(lp + 128), km = *(const LAS f32x4*)(lp + 192), r = *(const LAS f32x4*)(lp + 256);
                float v = vp[0];
#pragma unroll 1
                for (int g16 = 0; g16 < SC_CH / 16; ++g16) {
                    float ykeep = 0.f;
#pragma unroll
                    for (int s16 = 0; s16 < 16; ++s16) {
                        f32x4 nkk = kk, nw = w, nbb = bb, nkm = km, nr = r; float nv = v;
                        if (s16 < 15 || g16 + 1 < SC_CH / 16) {
                            const LAS float* np = lp + (g16 * 16 + s16 + 1) * SC_STEP;
                            nkk = *(const LAS f32x4*)(np); nw = *(const LAS f32x4*)(np + 64); nbb = *(const LAS f32x4*)(np + 128); nkm = *(const LAS f32x4*)(np + 192); nr = *(const LAS f32x4*)(np + 256);
                            nv = vp[(g16 * 16 + s16 + 1) * SC_STEP];
                        }
                        const f32x2 dd = Sa * kk.xy + Sb * kk.zw;
                        const float d = red16(dd.x + dd.y);
                        const f32x2 ta = km.xy * v - bb.xy * d, tb2 = km.zw * v - bb.zw * d;
                        Sa = Sa * w.xy + ta; Sb = Sb * w.zw + tb2;
                        const f32x2 yy = Sa * r.xy + Sb * r.zw;
                        const float y = red16(yy.x + yy.y);
                        ykeep = (jg == s16) ? y : ykeep;
                        kk = nkk; w = nw; bb = nbb; km = nkm; r = nr; v = nv;
                    }
                    yp[g16 * 16384] = ykeep;
                }
                __syncthreads();
            }
            __builtin_amdgcn_s_setprio(0);
        }
    }
}

__device__ __forceinline__ void post_phase(const Ctx cx, const Params& p, int l) {
    const int wave = cx.tid >> 6, lane = cx.tid & 63, jg = lane & 15;
    const float* YRAW = (const float*)(p.ws + WS_PRW); const float* SC = (const float*)(p.ws + WS_SCAN);
    const bf16_t* SB = (const bf16_t*)(SC + ARR); const bf16_t* KMi = SB + 2 * ARR, *Ri = SB + 3 * ARR, *Vi = SB + 4 * ARR; const bf16_t* Gb = (const bf16_t*)(p.ws + WS_G); bf16_t* YR = (bf16_t*)(p.ws + WS_YR);
    const float* rk = p.in[14] + l * C_; const float* lw = p.in[15] + l * C_; const float* lb = p.in[16] + l * C_;
    const int NIT = M_ * 16 / 4, stride = cx.G * 8;
    int it = cx.bx * 8 + wave;
    f32x4 ny = {0.f, 0.f, 0.f, 0.f}; u32x2 nr = {0u, 0u}, nkm = nr, nv = nr, ng = nr;
#define POST_LOAD(it_) do { const int row_ = ((it_) >> 4) * 4 + (lane >> 4), c_ = ((it_) & 15) * 64 + 4 * jg; const unsigned o_ = tix(row_, c_); \
        ny = *(const f32x4*)(YRAW + o_); nr = *(const u32x2*)(Ri + o_); nkm = *(const u32x2*)(KMi + o_); nv = *(const u32x2*)(Vi + o_); ng = *(const u32x2*)(Gb + o_); } while (0)
    if (it < NIT) POST_LOAD(it);
#pragma unroll 1
    for (; it < NIT; it += stride) {
        const int row = (it >> 4) * 4 + (lane >> 4), hd = it & 15, c = hd * 64 + 4 * jg;
        const f32x4 y = ny; const u32x2 pr_ = nr, pkm = nkm, pv_ = nv, pg = ng;
        if (it + stride < NIT) POST_LOAD(it + stride);
        const f32x4 rkc = *(const f32x4*)(rk + c), lwc = *(const f32x4*)(lw + c), lbc = *(const f32x4*)(lb + c);
        const float mean = red16((y[0] + y[1]) + (y[2] + y[3])) * (1.0f / 64.0f);
        const f32x4 d = y - mean; const float var = red16(dot4(d, d)) * (1.0f / 64.0f); const float rstd = rsqrtf(var + LNX_EPS);
        const f32x4 r = unpk4_bf16(pr_), km = unpk4_bf16(pkm), v = unpk4_bf16(pv_), g = unpk4_bf16(pg);
        const float bonus = red16(dot4(r * km, rkc));
        const f32x4 outv = ((d * rstd) * lwc + lbc + bonus * v) * g;
        *(u32x2*)(YR + tixa((size_t)row, c, 1024)) = pk4_bf16(outv);
    }
#undef POST_LOAD
}

__device__ __forceinline__ void final_phase(const Ctx cx, const Params& p) {
    const float* X = (const float*)(p.ws + WS_XRES); const float* ss = (const float*)(p.ws + WS_SS) + (size_t)8 * M_ * 32; const float* g = p.in[3];
    const int wave = cx.tid >> 6, lane = cx.tid & 63, stride = cx.G * 8;
    int row = cx.bx * 8 + wave; f32x4 nx[8]; float nsq = 0.f;
    f32x4 gv[8];
#pragma unroll
    for (int i = 0; i < 8; ++i) gv[i] = *(const f32x4*)(g + (lane + 64 * i) * 4);
    if (row < M_) { nsq = ss[(size_t)row * 32 + (lane & 31)];
#pragma unroll
        for (int i = 0; i < 8; ++i) nx[i] = ((const f32x4*)(X + (size_t)row * D_))[lane + 64 * i]; }
#pragma unroll 1
    for (; row < M_; row += stride) {
        f32x4 v[8]; float sq = nsq;
#pragma unroll
        for (int i = 0; i < 8; ++i) v[i] = nx[i];
        if (row + stride < M_) { nsq = ss[(size_t)(row + stride) * 32 + (lane & 31)];
#pragma unroll
            for (int i = 0; i < 8; ++i) nx[i] = ((const f32x4*)(X + (size_t)(row + stride) * D_))[lane + 64 * i]; }
#pragma unroll
        for (int o = 16; o >= 1; o >>= 1) sq += __shfl_xor(sq, o);
        const float rs = rsqrtf(sq * (1.0f / 2048.0f) + NORM_EPS);
        f32x4* orow = (f32x4*)(p.out + (size_t)row * D_);
#pragma unroll
        for (int i = 0; i < 8; ++i) orow[lane + 64 * i] = v[i] * rs * gv[i];
    }
}

#define XB_TMO      128
#define XB_XCNT(j)  (256  + 64 * (j))
#define XB_XSUB(j)  (1280 + 64 * (j))
#define XB_XGEN(j)  (2304 + 64 * (j))
#define XB_TOP      3328
#define XB_TOPGEN   3392
#define XCD_BAR_WORDS 3456
#define XB_SPIN_CAP (1u << 20)
__device__ __forceinline__ unsigned xb_ld(unsigned* p)              { return __hip_atomic_load(p, __ATOMIC_RELAXED, __HIP_MEMORY_SCOPE_AGENT); }
__device__ __forceinline__ unsigned xb_add(unsigned* p, unsigned v) { return __hip_atomic_fetch_add(p, v, __ATOMIC_RELAXED, __HIP_MEMORY_SCOPE_AGENT); }
__device__ __forceinline__ unsigned xb_xcc_id() { return (unsigned)__builtin_amdgcn_s_getreg((3 << 11) | 20) & 0xFu; }
#define XB_SPIN(cond, bar) do { unsigned _sp = 0; while (cond) { __builtin_amdgcn_s_sleep(1); \
    if ((++_sp & 255u) == 0u) { if (xb_ld(&(bar)[XB_TMO])) break; if (_sp > XB_SPIN_CAP) { atomicAdd(&(bar)[XB_TMO], 1u); break; } } } } while (0)
struct XcdBarrier { unsigned* bar; unsigned x; volatile LAS unsigned* st; };
__device__ __forceinline__ XcdBarrier xcd_barrier_post(unsigned* bar, volatile LAS unsigned* st, bool leader) {
    XcdBarrier b; b.bar = bar; b.x = xb_xcc_id(); b.st = st;
    if (leader) (void)xb_add(&bar[XB_XCNT(b.x)], 1u);
    return b;
}
__device__ __forceinline__ void xcd_barrier_complete(unsigned* bar, unsigned x, unsigned& nloc, unsigned& nx) {
    const unsigned G = gridDim.x * gridDim.y * gridDim.z;
    unsigned sum, cnt, mine, sp = 0u;
    for (;;) {
        sum = 0u; cnt = 0u; mine = 0u;
#pragma unroll
        for (unsigned j = 0; j < 16; ++j) { const unsigned c = xb_ld(&bar[XB_XCNT(j)]); sum += c; cnt += (c > 0u) ? 1u : 0u; mine = (j == x) ? c : mine; }
        if (sum == G) break;
        __builtin_amdgcn_s_sleep(1);
        if ((++sp & 255u) == 0u) { if (xb_ld(&bar[XB_TMO])) break; if (sp > XB_SPIN_CAP) { atomicAdd(&bar[XB_TMO], 1u); break; } }
    }
    nloc = mine > 0u ? mine : 1u; nx = cnt > 0u ? cnt : 1u;
}
__device__ __forceinline__ void xcd_barrier(const XcdBarrier& b, bool leader) {
    asm volatile("s_waitcnt vmcnt(0)" ::: "memory");
    __syncthreads();
    if (leader) {
        unsigned* bar = b.bar;
        __builtin_amdgcn_s_waitcnt(0);
        unsigned nloc = b.st[0], nx = b.st[1];
        if (nloc == 0u) { xcd_barrier_complete(bar, b.x, nloc, nx); b.st[0] = nloc; b.st[1] = nx; }
        const unsigned old = xb_add(&bar[XB_XSUB(b.x)], 1u);
        const unsigned gen = old / nloc;
        if (old + 1u == (gen + 1u) * nloc) {
            __builtin_amdgcn_fence(__ATOMIC_RELEASE, "agent");
            asm volatile("s_waitcnt vmcnt(0)" ::: "memory");
            const unsigned og = xb_add(&bar[XB_TOP], 1u);
            const unsigned tg = og / nx;
            if (og + 1u == (tg + 1u) * nx) xb_add(&bar[XB_TOPGEN], 1u);
            else XB_SPIN(xb_ld(&bar[XB_TOPGEN]) == tg, bar);
            __builtin_amdgcn_fence(__ATOMIC_ACQUIRE, "agent");
            xb_add(&bar[XB_XGEN(b.x)], 1u);
            asm volatile("s_waitcnt vmcnt(0)" ::: "memory");
        } else {
            XB_SPIN(xb_ld(&bar[XB_XGEN(b.x)]) == gen, bar);
            __builtin_amdgcn_fence(__ATOMIC_ACQUIRE, "agent");
            asm volatile("s_waitcnt vmcnt(0)" ::: "memory");
        }
    }
    __syncthreads();
}

constexpr int N_PHASES = 34;
__global__ void __launch_bounds__(512, 2) fwd_kernel(Params p_arg) {
    extern __shared__ __attribute__((aligned(16))) unsigned char smem[];
    LAS unsigned char* lds = (LAS unsigned char*)smem;
    cg::grid_group grid = cg::this_grid();
    const int ph_lo = p_arg.ph_lo, ph_hi = p_arg.ph_hi;
    volatile LAS unsigned* bst = (volatile LAS unsigned*)(lds + LDS_STAGE);
    const int wave_id_ = __builtin_amdgcn_readfirstlane((int)threadIdx.x >> 6);
    if (threadIdx.x == 0) { bst[0] = 0u; bst[1] = 0u; }
    __syncthreads();
    XcdBarrier xbar; xbar.bar = (unsigned*)(p_arg.ws + WS_BAR); xbar.x = 0; xbar.st = bst;
    if (ph_hi - ph_lo > 1) xbar = xcd_barrier_post((unsigned*)(p_arg.ws + WS_BAR), bst, threadIdx.x == 0);
    for (int ph = ph_lo; ph < ph_hi; ++ph) {
        if (ph > ph_lo) { if (ph_lo < 0) grid.sync(); else { int l0_; asm volatile("v_mbcnt_lo_u32_b32 %0, -1, 0\n\tv_mbcnt_hi_u32_b32 %0, -1, %0" : "=v"(l0_)); xcd_barrier(xbar, wave_id_ == 0 && l0_ == 0); } }
        Ctx cx; { int ln_; asm volatile("v_mbcnt_lo_u32_b32 %0, -1, 0\n\tv_mbcnt_hi_u32_b32 %0, -1, %0" : "=v"(ln_));
        int t_ = wave_id_ * 64 + ln_, b_ = blockIdx.x, g_ = gridDim.x; asm volatile("" : "+v"(t_)); asm volatile("" : "+s"(b_)); asm volatile("" : "+s"(g_)); cx.tid = t_; cx.bx = b_; cx.G = g_; }
        const Params& p = p_arg;
        const int G = cx.G, bx = cx.bx;
        unsigned char* ws = p.ws;
        const bf16_t* XB = (const bf16_t*)(ws + WS_XB); float* SS = (float*)(ws + WS_SS); float* XRES = (float*)(ws + WS_XRES);
        if (ph == 0) { for (int r_ = 0; r_ < REP_P0; ++r_) p0_prologue(cx, p, lds); continue; }
        if (ph == N_PHASES - 1) { final_phase(cx, p); continue; }
        const int l = (ph - 1) >> 3, k = (ph - 1) & 7;
        const bf16_t* WL = (const bf16_t*)(ws + WS_W) + (size_t)l * LSTRIDE;
        pg8::StaticOrder S;
        if (k == 0) {
            pg8::Gemm g{XB, WL + OFF_WIN, M_, NP_, D_}; S.init(M_, NP_, G, bx);
            rs_table_fill(cx, lds, S, SS + (size_t)(2 * l) * M_ * 32);
            EpiInProj E{(const LAS float*)(lds + LDS_RST), (bf16_t*)(ws + WS_QB), (bf16_t*)(ws + WS_KB), (bf16_t*)(ws + WS_VT), (float*)(ws + WS_PRW), (bf16_t*)(ws + WS_SG)};
            for (int r_ = 0; r_ < REP_INPROJ; ++r_) pg8::gemm_phase(cx, lds, g, S, E);
            if (G == 256 && bx >= 128 && l < 3) conv_run(cx, p, lds, (l + 1) * 7552 + (bx - 128), CV_SLOT, 128, false);
        } else if (k == 1) { for (int r_ = 0; r_ < REP_PREP; ++r_) prep_phase(cx, p, lds, l); if (G != 256) attn_phase(cx, p, l); }
        else if (k == 2) { for (int r_ = 0; r_ < REP_SCAN; ++r_) scan_phase(cx, p, lds, l, G == 256); }
        else if (k == 3) { for (int r_ = 0; r_ < REP_POST; ++r_) post_phase(cx, p, l); }
        else if (k == 4) {
            pg8::PairOrder SP; SP.init(M_, D_, G, bx);
            pg8::Gemm g{(const bf16_t*)(ws + WS_YA), WL + OFF_WBA, 2 * M_, 2 * D_, C_};
            EpiBranchPair E{(const bf16_t*)(ws + WS_SG), (bf16_t*)(ws + WS_MRG)};
            pg8::gemm_phase(cx, lds, g, SP, E);
        } else if (k == 5) {
            pg8::Gemm g{(const bf16_t*)(ws + WS_MRG), WL + OFF_WO, M_, D_, D_}; S.init(M_, D_, G, bx);
            EpiResid E{l == 0 ? p.in[0] : XRES, XRES, (bf16_t*)(ws + WS_XB), SS + (size_t)(2 * l + 1) * M_ * 32};
            pg8::gemm_phase(cx, lds, g, S, E);
        } else if (k == 6) {
            pg8::Gemm g{XB, WL + OFF_WGU, M_, 2 * FH_, D_}; S.init(M_, 2 * FH_, G, bx);
            rs_table_fill(cx, lds, S, SS + (size_t)(2 * l + 1) * M_ * 32);
            EpiFFN E{(const LAS float*)(lds + LDS_RST), (bf16_t*)(ws + WS_PRW)};
            for (int r_ = 0; r_ < REP_GU; ++r_) pg8::gemm_phase(cx, lds, g, S, E);
            if (G == 256 && bx >= 128 && l < 3) conv_run(cx, p, lds, (l + 1) * 7552 + CV_Q + (bx - 128), CV_SLOT, 128, false);
        } else {
            pg8::Gemm g{(const bf16_t*)(ws + WS_PRW), WL + OFF_WD, M_, D_, FH_}; S.init(M_, D_, G, bx);
            EpiResid E{XRES, XRES, (bf16_t*)(ws + WS_XB), SS + (size_t)(2 * l + 2) * M_ * 32};
            pg8::gemm_phase(cx, lds, g, S, E);
        }
    }
}

extern "C" void kernel_launch(void* const* d_in, const int* in_sizes, int n_in, void* d_out, int out_size, void* d_ws, size_t ws_size, hipStream_t stream) {
    static int grid_blocks = 0;
    if (!grid_blocks) {
        if (n_in != 27 || ws_size < WS_END) { fprintf(stderr, "kernel_launch: unexpected n_in %d / ws_size %zu (need %zu)\n", n_in, ws_size, (size_t)WS_END); grid_blocks = -1; return; }
        int dev = 0, cus = 0, per_cu = 0;
        hipGetDevice(&dev);
        hipDeviceGetAttribute(&cus, hipDeviceAttributeMultiprocessorCount, dev);
        if (hipFuncSetAttribute((const void*)fwd_kernel, hipFuncAttributeMaxDynamicSharedMemorySize, LDS_BYTES) != hipSuccess) { fprintf(stderr, "kernel_launch: hipFuncSetAttribute failed\n"); grid_blocks = -1; return; }
        hipOccupancyMaxActiveBlocksPerMultiprocessor(&per_cu, (const void*)fwd_kernel, 512, LDS_BYTES);
        if (per_cu < 1) { fprintf(stderr, "kernel_launch: occupancy query says %d blocks per CU\n", per_cu); per_cu = 1; }
        (void)hipGetLastError();
        grid_blocks = cus;
        if (grid_blocks < 236) { fprintf(stderr, "kernel_launch: %d CUs: the per-phase rstd table holds 6 units per workgroup (needs >= 236 workgroups)\n", cus); grid_blocks = -1; return; }
    }
    if (grid_blocks < 0) return;
    Params p{};
    for (int i = 0; i < 27; ++i) p.in[i] = (const float*)d_in[i];
    p.out = (float*)d_out; p.ws = (unsigned char*)d_ws;
#if FUSED
    p.ph_lo = 0; p.ph_hi = N_PHASES;
    if (hipMemsetAsync((unsigned char*)d_ws + WS_BAR, 0, 16384, stream) != hipSuccess) { fprintf(stderr, "kernel_launch: memset of the barrier words failed\n"); return; }
    void* args[] = {&p};
    hipError_t e = hipLaunchCooperativeKernel((const void*)fwd_kernel, dim3(grid_blocks), dim3(512), args, LDS_BYTES, stream);
    if (e != hipSuccess) fprintf(stderr, "cooperative launch failed: %s (grid %d)\n", hipGetErrorString(e), grid_blocks);
#else
    for (int ph = 0; ph < N_PHASES; ++ph) {
        p.ph_lo = ph; p.ph_hi = ph + 1;
        hipLaunchKernelGGL(fwd_kernel, dim3(grid_blocks), dim3(512), LDS_BYTES, stream, p);
    }
#endif
}
```

```cpp
#include <hip/hip_runtime.h>
#include <hip/hip_cooperative_groups.h>
#include <cstdio>
namespace cg = cooperative_groups;

#ifndef FUSED
#define FUSED 1
#endif

#ifndef REP_P0
#define REP_P0 1
#endif
#ifndef REP_INPROJ
#define REP_INPROJ 1
#endif
#ifndef REP_PREP
#define REP_PREP 1
#endif
#ifndef REP_ATTN
#define REP_ATTN 1
#endif
#ifndef REP_SCAN
#define REP_SCAN 1
#endif
#ifndef REP_POST
#define REP_POST 1
#endif
#ifndef REP_BR
#define REP_BR 1
#endif
#ifndef REP_GU
#define REP_GU 1
#endif

#define LAS __attribute__((address_space(3)))
typedef unsigned short bf16_t;
typedef short bf16x8 __attribute__((ext_vector_type(8)));
typedef float f32x2 __attribute__((ext_vector_type(2)));
typedef float f32x4 __attribute__((ext_vector_type(4)));
typedef float f32x16 __attribute__((ext_vector_type(16)));
typedef unsigned u32x2 __attribute__((ext_vector_type(2)));
typedef unsigned u32x4 __attribute__((ext_vector_type(4)));
typedef __bf16 nbf2 __attribute__((ext_vector_type(2)));

constexpr int M_ = 8192, D_ = 2048, T_ = 2048, C_ = 1024, FH_ = 5632, NP_ = 9216, NIN_ = 8992, PRWW_ = 3584;
constexpr float NORM_EPS = 1e-5f, LNX_EPS = 64e-5f;

constexpr size_t OFF_WIN = 0, OFF_WBA = OFF_WIN + (size_t)NP_ * D_, OFF_WBR = OFF_WBA + (size_t)D_ * C_, OFF_WO = OFF_WBR + (size_t)D_ * C_,
                 OFF_WGU = OFF_WO + (size_t)D_ * D_, OFF_WD = OFF_WGU + (size_t)2 * FH_ * D_, LSTRIDE = OFF_WD + (size_t)D_ * FH_;
constexpr int UPS_L = 1024 * 320;
constexpr int UPS_D = 0, UPS_I = 65536, UPS_G = 131072, UPS_V = 294912;
constexpr size_t ARR = (size_t)M_ * C_;

constexpr size_t WS_W = 0;
constexpr size_t WS_UPS = WS_W + 4 * LSTRIDE * 2;
constexpr size_t WS_XRES = WS_UPS + (size_t)4 * UPS_L * 2;
constexpr size_t WS_XB = WS_XRES + (size_t)M_ * D_ * 4;
constexpr size_t WS_SS = WS_XB + (size_t)M_ * D_ * 2;
constexpr size_t WS_QB = WS_SS + (size_t)9 * M_ * 32 * 4;
constexpr size_t WS_KB = WS_QB + ARR * 2;
constexpr size_t WS_VT = WS_KB + (size_t)M_ * 256 * 2;
constexpr size_t WS_SG = WS_VT + (size_t)M_ * 256 * 2;
constexpr size_t WS_VFIRST = WS_SG + (size_t)M_ * 4096 * 2;
constexpr size_t WS_G = WS_VFIRST + ARR * 4;
constexpr size_t WS_YA = WS_G + ARR * 2;
constexpr size_t WS_YR = WS_YA + ARR * 2;
constexpr size_t WS_MRG = WS_YR + ARR * 2;
constexpr size_t WS_PRW = WS_MRG + (size_t)M_ * D_ * 2;
constexpr size_t WS_SCAN = WS_PRW + (size_t)M_ * PRWW_ * 4;
constexpr size_t WS_BAR = WS_SCAN + 6 * ARR * 4;
constexpr size_t WS_END = WS_BAR + 16384;
static_assert((size_t)M_ * FH_ * 2 <= (size_t)M_ * PRWW_ * 4, "ACT alias");

constexpr int LDS_STAGE = 131072, LDS_RST = LDS_STAGE + 16, LDS_BYTES = LDS_RST + 6 * 1024;

struct Params { const float* in[27]; float* out; unsigned char* ws; int ph_lo, ph_hi; };
struct Ctx { int tid, bx, G; };

__device__ __forceinline__ unsigned pk_bf16(float lo, float hi) { f32x2 v = {lo, hi}; nbf2 b = __builtin_convertvector(v, nbf2); return __builtin_bit_cast(unsigned, b); }
__device__ __forceinline__ u32x2 pk4_bf16(f32x4 v) { u32x2 r; r.x = pk_bf16(v[0], v[1]); r.y = pk_bf16(v[2], v[3]); return r; }
__device__ __forceinline__ f32x4 unpk4_bf16(u32x2 w) { f32x4 r; r[0] = __uint_as_float(w.x << 16); r[1] = __uint_as_float(w.x & 0xffff0000u); r[2] = __uint_as_float(w.y << 16); r[3] = __uint_as_float(w.y & 0xffff0000u); return r; }
__device__ __forceinline__ float sigm(float x) { return __builtin_amdgcn_rcpf(1.0f + __expf(-x)); }
__device__ __forceinline__ float tanh_fast(float x) { return 1.0f - 2.0f * __builtin_amdgcn_rcpf(1.0f + __expf(2.0f * x)); }
__device__ __forceinline__ f32x4 sigm4(f32x4 v) { f32x4 r; r[0] = sigm(v[0]); r[1] = sigm(v[1]); r[2] = sigm(v[2]); r[3] = sigm(v[3]); return r; }
__device__ __forceinline__ float dot4(f32x4 a, f32x4 b) { return (a[0] * b[0] + a[1] * b[1]) + (a[2] * b[2] + a[3] * b[3]); }
__device__ __forceinline__ float dppf(float x, const int ctrl) { return x; }
#define DPP_ADD(x, ctrl) ((x) + __int_as_float(__builtin_amdgcn_update_dpp(0, __float_as_int(x), (ctrl), 0xF, 0xF, false)))
__device__ __forceinline__ float red16(float x) { x = DPP_ADD(x, 0xB1); x = DPP_ADD(x, 0x4E); x = DPP_ADD(x, 0x141); x = DPP_ADD(x, 0x140); return x; }

__device__ __forceinline__ unsigned prw_row(int row) { return (unsigned)(row >> 4) * (unsigned)(PRWW_ * 16) + (unsigned)(row & 15) * 16u; }
__device__ __forceinline__ unsigned prw_col(int col) { return (unsigned)(col >> 4) * 256u + (unsigned)(col & 15); }
__device__ __forceinline__ unsigned tix(int row, int col) { return (unsigned)(row >> 4) * 16384u + (unsigned)(col >> 4) * 256u + (unsigned)(row & 15) * 16u + (unsigned)(col & 15); }
__device__ __forceinline__ size_t tixa(size_t r, int k, int K) { return ((r >> 4) * (size_t)(K >> 5) + (size_t)(k >> 5)) * 512 + (size_t)((int)(r & 15) * 32 + (k & 31)); }
__device__ __forceinline__ float row_ss(const float* ss, int row, int fq) {
    const f32x4 a = *(const f32x4*)(ss + (size_t)row * 32 + fq * 8), b = *(const f32x4*)(ss + (size_t)row * 32 + fq * 8 + 4);
    float s = ((a[0] + a[1]) + (a[2] + a[3])) + ((b[0] + b[1]) + (b[2] + b[3]));
    s += __shfl_xor(s, 16); s += __shfl_xor(s, 32); return s;
}

namespace pg8 {
constexpr int BM = 256, BK = 64, HALF = 128, HTB = HALF * BK * 2, STAGE_BYTES = 8 * HTB, NXCD = 8, WGM = 8;
__device__ __forceinline__ int lds_byte(int r, int c) { const int st = (r >> 4) * 2 + (c >> 5), rr = r & 15, cc = c & 31, ob = rr * 64 + cc * 2; return st * 1024 + (ob ^ (((ob >> 9) & 1) << 5)); }
__device__ __forceinline__ void stage_rc(int b, int& R, int& Cc) { const int st = b / 1024, sb = b % 1024, swz = sb ^ (((sb >> 9) & 1) << 5); R = (st >> 1) * 16 + swz / 64; Cc = (st & 1) * 32 + (swz % 64) / 2; }
struct Unit { int pm, pn, idx; };
struct Gemm { const bf16_t* A; const bf16_t* Bt; int M, N, K; };
struct StaticOrder {
    int nM, nN, nwg, G, c;
    __device__ void init(int M, int N, int G_, int c_) { nM = M / BM; nN = N / BM; nwg = nM * nN; G = G_; c = c_; }
    __device__ bool next(int i, Unit& u) const {
        const long L = (long)i * G + c; if (L >= nwg) return false;
        int wgid = (int)L; { const int q = nwg / NXCD, r = nwg % NXCD, xcd = wgid % NXCD, off = wgid / NXCD; wgid = (xcd < r ? xcd * (q + 1) : r * (q + 1) + (xcd - r) * q) + off; }
        const int nig = WGM * nN, gid = wgid / nig, fm = gid * WGM, gsz = (nM - fm) < WGM ? (nM - fm) : WGM;
        u.pm = fm + ((wgid % nig) % gsz); u.pn = (wgid % nig) / gsz; u.idx = i; return true;
    }
};

struct PairOrder : StaticOrder {
    __device__ bool next(int i, Unit& u) const { if (!StaticOrder::next(i >> 1, u)) return false; if (i & 1) { u.pm += 32; u.pn += 8; } return true; }
};

template <class Epi, class Sched>
__device__ __forceinline__ void gemm_phase(const Ctx cx, LAS unsigned char* lds, const Gemm g, const Sched& S, const Epi& E) {
    const int tid = cx.tid, wid = __builtin_amdgcn_readfirstlane(tid >> 6), lane = tid & 63, wr = wid >> 2, wc = wid & 3, fr = lane & 15, fq = lane >> 4;
    const int K = g.K, nt = K / BK;
    unsigned voffA[2];
#pragma unroll
    for (int i = 0; i < 2; ++i) { int R, Cc; stage_rc(tid * 16 + i * 8192, R, Cc); voffA[i] = (unsigned)(((R >> 4) * (K >> 5) + (Cc >> 5)) * 512 + (R & 15) * 32 + (Cc & 31)) * 2u; }
    const size_t kstep = (size_t)(2 * 512 * 2);
    const size_t hstep = (size_t)HALF * K * 2;
    const size_t tstep = 2 * hstep;
    const unsigned ldsw = (unsigned)wid * 1024u;
    const int aoff = lds_byte(wr * 64 + fr, fq * 8), boff = lds_byte(wc * 32 + fr, fq * 8);
#define PG8_SA(b, h) (((b) * 2 + (h)) * HTB)
#define PG8_SB(b, h) ((4 + (b) * 2 + (h)) * HTB)
#define PG8_STAGE(bufoff, gbase) do { _Pragma("unroll") for (int _i = 0; _i < 2; ++_i) \
        __builtin_amdgcn_global_load_lds((const unsigned*)((const char*)(gbase) + voffA[_i]), (LAS unsigned*)(lds + (bufoff) + ldsw + _i * 8192), 16, 0, 0); } while (0)
#define PG8_LDA(dst, b, h) do { _Pragma("unroll") for (int m = 0; m < 4; ++m) _Pragma("unroll") for (int k = 0; k < 2; ++k) dst[m][k] = *(const LAS bf16x8*)(lds + PG8_SA(b, h) + aoff + m * 2048 + k * 1024); } while (0)
#define PG8_LDB(dst, b, h) do { _Pragma("unroll") for (int n = 0; n < 2; ++n) _Pragma("unroll") for (int k = 0; k < 2; ++k) dst[n][k] = *(const LAS bf16x8*)(lds + PG8_SB(b, h) + boff + n * 2048 + k * 1024); } while (0)
#define PG8_MMA(ai, bj, At, Bt) do { __builtin_amdgcn_s_setprio(1); _Pragma("unroll") for (int m = 0; m < 4; ++m) _Pragma("unroll") for (int n = 0; n < 2; ++n) _Pragma("unroll") for (int k = 0; k < 2; ++k) \
        acc[ai][bj][m][n] = __builtin_amdgcn_mfma_f32_16x16x32_bf16(Bt[n][k], At[m][k], acc[ai][bj][m][n], 0, 0, 0); __builtin_amdgcn_s_setprio(0); } while (0)
#define PG8_WAIT_V(n) asm volatile("s_waitcnt vmcnt(" #n ")" ::: "memory")
#define PG8_WAIT_L(n) asm volatile("s_waitcnt lgkmcnt(" #n ")" ::: "memory")
#define PG8_BAR __builtin_amdgcn_s_barrier()
#define PG8_SCHED __builtin_amdgcn_sched_barrier(0)
    Unit cur, nxt; int ui = 0;
    if (!S.next(0, cur)) return;
    f32x4 acc[2][2][4][2];
#pragma unroll
    for (int a = 0; a < 2; ++a)
#pragma unroll
        for (int b = 0; b < 2; ++b)
#pragma unroll
            for (int m = 0; m < 4; ++m)
#pragma unroll
                for (int n = 0; n < 2; ++n) acc[a][b][m][n] = (f32x4){0.f, 0.f, 0.f, 0.f};
    bf16x8 At[4][2], B0[2][2], B1[2][2];
    const char* cA = (const char*)g.A + (size_t)cur.pm * tstep; const char* cB = (const char*)g.Bt + (size_t)cur.pn * tstep;
    PG8_STAGE(PG8_SB(0, 0), cB); PG8_STAGE(PG8_SA(0, 0), cA); PG8_STAGE(PG8_SB(0, 1), cB + hstep); PG8_STAGE(PG8_SA(0, 1), cA + hstep);
    if (wr == 1) PG8_BAR;
    PG8_WAIT_V(4); PG8_BAR;
    PG8_STAGE(PG8_SB(1, 0), cB + kstep); PG8_STAGE(PG8_SA(1, 0), cA + kstep); PG8_STAGE(PG8_SB(1, 1), cB + hstep + kstep);
    PG8_WAIT_V(6); PG8_BAR;
    for (;;) {
        const bool has_next = S.next(ui + 1, nxt);
        const char* nA = has_next ? (const char*)g.A + (size_t)nxt.pm * tstep : cA; const char* nB = has_next ? (const char*)g.Bt + (size_t)nxt.pn * tstep : cB;
        for (int t = 0; t < nt; t += 2) {
            const bool last = (t == nt - 2);
            const char* a1 = cA + (size_t)(t + 1) * kstep;
            const char* a2 = last ? nA : cA + (size_t)(t + 2) * kstep; const char* b2 = last ? nB : cB + (size_t)(t + 2) * kstep;
            const char* a3 = a2 + kstep; const char* b3 = b2 + kstep;
            PG8_LDB(B0, 0, 0); PG8_SCHED; PG8_LDA(At, 0, 0); PG8_STAGE(PG8_SA(1, 1), a1 + hstep);
            PG8_WAIT_L(8); PG8_BAR; PG8_WAIT_L(0); PG8_MMA(0, 0, At, B0); PG8_BAR; PG8_SCHED;
            PG8_LDB(B1, 0, 1); PG8_STAGE(PG8_SB(0, 0), b2);
            PG8_BAR; PG8_WAIT_L(0); PG8_MMA(0, 1, At, B1); PG8_BAR;
            PG8_LDA(At, 0, 1); PG8_STAGE(PG8_SA(0, 0), a2);
            PG8_BAR; PG8_WAIT_L(0); PG8_MMA(1, 0, At, B0); PG8_BAR; PG8_SCHED;
            PG8_STAGE(PG8_SB(0, 1), b2 + hstep);
            PG8_WAIT_V(6); PG8_BAR; PG8_MMA(1, 1, At, B1); PG8_BAR;
            PG8_LDB(B0, 1, 0); PG8_SCHED; PG8_LDA(At, 1, 0); PG8_STAGE(PG8_SA(0, 1), a2 + hstep);
            PG8_WAIT_L(8); PG8_BAR; PG8_WAIT_L(0); PG8_MMA(0, 0, At, B0); PG8_BAR; PG8_SCHED;
            PG8_LDB(B1, 1, 1); PG8_STAGE(PG8_SB(1, 0), b3);
            PG8_BAR; PG8_WAIT_L(0); PG8_MMA(0, 1, At, B1); PG8_BAR;
            PG8_LDA(At, 1, 1); PG8_STAGE(PG8_SA(1, 0), a3);
            PG8_BAR; PG8_WAIT_L(0); PG8_MMA(1, 0, At, B0); PG8_BAR; PG8_SCHED;
            PG8_STAGE(PG8_SB(1, 1), b3 + hstep);
            PG8_WAIT_V(6); PG8_BAR; PG8_MMA(1, 1, At, B1); PG8_BAR;
        }
        bool keep = false;
        if constexpr (Epi::PAIR) { if (cur.pm < 32) { E.mid(acc, cur, wr, wc, fr, fq); keep = true; } else E(acc, cur, wr, wc, fr, fq); }
        else E(acc, cur, wr, wc, fr, fq);
        if (!has_next) break;
        if (!keep)
#pragma unroll
        for (int a = 0; a < 2; ++a)
#pragma unroll
            for (int b = 0; b < 2; ++b)
#pragma unroll
                for (int m = 0; m < 4; ++m)
#pragma unroll
                    for (int n = 0; n < 2; ++n) acc[a][b][m][n] = (f32x4){0.f, 0.f, 0.f, 0.f};
        cur = nxt; cA = nA; cB = nB; ++ui;
    }
    PG8_WAIT_V(0);
    if (wr == 0) PG8_BAR;
    PG8_BAR;
#undef PG8_SA
#undef PG8_SB
#undef PG8_STAGE
#undef PG8_LDA
#undef PG8_LDB
#undef PG8_MMA
#undef PG8_WAIT_V
#undef PG8_WAIT_L
#undef PG8_BAR
#undef PG8_SCHED
}
}

typedef f32x4 AccT[2][2][4][2];

__device__ __forceinline__ void rs_table_fill(const Ctx cx, LAS unsigned char* lds, const pg8::StaticOrder& S, const float* ss) {
    LAS float* tab = (LAS float*)(lds + LDS_RST);
    const int t = cx.tid & 255, par = cx.tid >> 8;
    float sq[3]; bool ok[3];
#pragma unroll
    for (int k = 0; k < 3; ++k) {
        pg8::Unit u; ok[k] = S.next(2 * k + par, u); sq[k] = 0.f;
        if (ok[k]) { const float* sp = ss + (size_t)(u.pm * 256 + t) * 32;
#pragma unroll
            for (int j = 0; j < 8; ++j) { const f32x4 a = *(const f32x4*)(sp + 4 * j); sq[k] += (a[0] + a[1]) + (a[2] + a[3]); } }
    }
#pragma unroll
    for (int k = 0; k < 3; ++k) if (ok[k]) tab[(2 * k + par) * 256 + t] = rsqrtf(sq[k] * (1.0f / 2048.0f) + NORM_EPS);
    __syncthreads();
}
struct EpiInProj {
    static constexpr bool PAIR = false;
    const LAS float* rst; bf16_t* QB; bf16_t* KB; bf16_t* VT; float* PRW; bf16_t* SG;
    __device__ __forceinline__ void operator()(const AccT& acc, const pg8::Unit& u, int wr, int wc, int fr, int fq) const {
        const int row0 = u.pm * 256 + wr * 64 + fr, col0 = u.pn * 256 + wc * 32 + 4 * fq; const int pn = u.pn;
#pragma unroll
        for (int ai = 0; ai < 2; ++ai)
#pragma unroll
            for (int m = 0; m < 4; ++m) {
                const int row = row0 + ai * 128 + m * 16; const float rs = rst[u.idx * 256 + (row - u.pm * 256)];
#pragma unroll
                for (int bj = 0; bj < 2; ++bj) {
                    if (pn >= 20) {
                        const u32x2 a = pk4_bf16(sigm4(acc[ai][bj][m][0] * rs)), b = pk4_bf16(sigm4(acc[ai][bj][m][1] * rs));
                        u32x4 w; w.x = a.x; w.y = a.y; w.z = b.x; w.w = b.y;
                        *(u32x4*)(SG + tixa((size_t)row, (pn * 256 + bj * 128 + wc * 32 - 5120) + 8 * fq, 4096)) = w;
                    } else
#pragma unroll
                    for (int n = 0; n < 2; ++n) {
                        const int c = col0 + bj * 128 + n * 16; const f32x4 v = acc[ai][bj][m][n] * rs;
                        if (pn < 4) *(u32x2*)(QB + (size_t)row * 1024 + c) = pk4_bf16(v);
                        else if (pn == 4) { const int cc = c - 1024, kvh = cc >> 6, d = cc & 63, b = row >> 11, t = row & 2047;
                            *(u32x2*)(KB + ((size_t)((b * 4 + kvh) * 4 + (d >> 4)) * 2048 + t) * 16 + (d & 15)) = pk4_bf16(v); }
                        else if (pn == 5) { const int cc = c - 1280, kvh = cc >> 6, d = cc & 63, b = row >> 11, t = row & 2047; bf16_t* vp = VT + ((size_t)(b * 4 + kvh) * 512 + (t >> 2)) * 256 + d * 4 + (t & 3);
                            const u32x2 w = pk4_bf16(v); vp[0] = (bf16_t)(w.x & 0xffff); vp[4] = (bf16_t)(w.x >> 16); vp[8] = (bf16_t)(w.y & 0xffff); vp[12] = (bf16_t)(w.y >> 16); }
                        else *(f32x4*)(PRW + (prw_row(row) + prw_col(c - 1536))) = v;
                    }
                }
            }
    }
};
template <int SECOND> struct EpiBranch {
    static constexpr bool PAIR = false;
    const bf16_t* SG; float* MRGF; bf16_t* MRG;
    __device__ __forceinline__ void operator()(const AccT& acc, const pg8::Unit& u, int wr, int wc, int fr, int fq) const {
        const int row0 = u.pm * 256 + wr * 64 + fr, col0 = u.pn * 256 + wc * 32 + 4 * fq;
#pragma unroll
        for (int ai = 0; ai < 2; ++ai)
#pragma unroll
            for (int m = 0; m < 4; ++m) {
                const int row = row0 + ai * 128 + m * 16;
#pragma unroll
                for (int bj = 0; bj < 2; ++bj)
#pragma unroll
                    for (int n = 0; n < 2; ++n) {
                        const int c = col0 + bj * 128 + n * 16;
                        const f32x4 sg = unpk4_bf16(*(const u32x2*)(SG + (size_t)row * 4096 + SECOND * 2048 + c));
                        float* mp = MRGF + (size_t)row * 2048 + c;
                        if (!SECOND) *(f32x4*)mp = sg * acc[ai][bj][m][n];
                        else { const f32x4 o = *(const f32x4*)mp + sg * acc[ai][bj][m][n]; *(u32x2*)(MRG + (size_t)row * 2048 + c) = pk4_bf16(o); }
                    }
            }
    }
};
struct EpiBranchPair {
    static constexpr bool PAIR = true;
    const bf16_t* SG; bf16_t* MRG;
    __device__ __forceinline__ void mid(AccT& acc, const pg8::Unit& u, int wr, int wc, int fr, int fq) const {
        const int row0 = u.pm * 256 + wr * 64 + fr, col0 = u.pn * 256 + wc * 32 + 4 * fq;
#pragma unroll
        for (int ai = 0; ai < 2; ++ai)
#pragma unroll
            for (int m = 0; m < 4; ++m) {
                const int row = row0 + ai * 128 + m * 16;
#pragma unroll
                for (int bj = 0; bj < 2; ++bj) {
                    const int gc = (u.pn * 256 + bj * 128 + wc * 32) + 8 * fq;
                    const u32x4 sa8 = *(const u32x4*)(SG + tixa((size_t)row, gc, 4096)), sb8 = *(const u32x4*)(SG + tixa((size_t)row, 2048 + gc, 4096));
#pragma unroll
                    for (int n = 0; n < 2; ++n) {
                        const f32x4 sa = unpk4_bf16(n ? (u32x2){sa8.z, sa8.w} : (u32x2){sa8.x, sa8.y}), sb = unpk4_bf16(n ? (u32x2){sb8.z, sb8.w} : (u32x2){sb8.x, sb8.y});
                        f32x4 q; q[0] = sa[0] * __builtin_amdgcn_rcpf(sb[0]); q[1] = sa[1] * __builtin_amdgcn_rcpf(sb[1]); q[2] = sa[2] * __builtin_amdgcn_rcpf(sb[2]); q[3] = sa[3] * __builtin_amdgcn_rcpf(sb[3]);
                        acc[ai][bj][m][n] = acc[ai][bj][m][n] * q;
                    }
                }
            }
    }
    __device__ __forceinline__ void operator()(const AccT& acc, const pg8::Unit& u, int wr, int wc, int fr, int fq) const {
        const int row0 = (u.pm - 32) * 256 + wr * 64 + fr, col0 = (u.pn - 8) * 256 + wc * 32 + 4 * fq;
#pragma unroll
        for (int ai = 0; ai < 2; ++ai)
#pragma unroll
            for (int m = 0; m < 4; ++m) {
                const int row = row0 + ai * 128 + m * 16;
#pragma unroll
                for (int bj = 0; bj < 2; ++bj) {
                    const u32x4 sb8 = *(const u32x4*)(SG + tixa((size_t)row, 2048 + ((u.pn - 8) * 256 + bj * 128 + wc * 32) + 8 * fq, 4096));
                    const u32x2 m0 = pk4_bf16(acc[ai][bj][m][0] * unpk4_bf16((u32x2){sb8.x, sb8.y})), m1 = pk4_bf16(acc[ai][bj][m][1] * unpk4_bf16((u32x2){sb8.z, sb8.w}));
                    u32x4 w; w.x = m0.x; w.y = m0.y; w.z = m1.x; w.w = m1.y;
                    *(u32x4*)(MRG + tixa((size_t)row, ((u.pn - 8) * 256 + bj * 128 + wc * 32) + 8 * fq, 2048)) = w;
                }
            }
    }
};
struct EpiResid {
    static constexpr bool PAIR = false;
    bf16_t* XB; float* ssn;
    __device__ __forceinline__ void operator()(const AccT& acc, const pg8::Unit& u, int wr, int wc, int fr, int fq) const {
        const int row0 = u.pm * 256 + wr * 64 + fr;
#pragma unroll
        for (int ai = 0; ai < 2; ++ai)
#pragma unroll
            for (int m = 0; m < 4; ++m) {
                const int row = row0 + ai * 128 + m * 16; float s = 0.f;
#pragma unroll
                for (int bj = 0; bj < 2; ++bj) {
                    bf16_t* xp = XB + tixa((size_t)row, (u.pn * 256 + bj * 128 + wc * 32) + 8 * fq, 2048);
                    const u32x4 b8 = *(const u32x4*)xp;
                    const f32x4 x0 = unpk4_bf16((u32x2){b8.x, b8.y}) + acc[ai][bj][m][0], x1 = unpk4_bf16((u32x2){b8.z, b8.w}) + acc[ai][bj][m][1];
                    s += dot4(x0, x0) + dot4(x1, x1);
                    const u32x2 p0 = pk4_bf16(x0), p1 = pk4_bf16(x1);
                    u32x4 w; w.x = p0.x; w.y = p0.y; w.z = p1.x; w.w = p1.y;
                    *(u32x4*)xp = w;
                }
                s += __shfl_xor(s, 16); s += __shfl_xor(s, 32);
                if (fq == 0) ssn[(size_t)row * 32 + u.pn * 4 + wc] = s;
            }
    }
};
struct EpiFFN {
    static constexpr bool PAIR = false;
    const LAS float* rst; bf16_t* ACT;
    __device__ __forceinline__ void operator()(const AccT& acc, const pg8::Unit& u, int wr, int wc, int fr, int fq) const {
        const int row0 = u.pm * 256 + wr * 64 + fr;
#pragma unroll
        for (int ai = 0; ai < 2; ++ai)
#pragma unroll
            for (int m = 0; m < 4; ++m) {
                const int row = row0 + ai * 128 + m * 16; const float rs = rst[u.idx * 256 + (row - u.pm * 256)];
                u32x4 w;
#pragma unroll
                for (int bj = 0; bj < 2; ++bj) {
                    const f32x4 g = acc[ai][bj][m][0] * rs, up = acc[ai][bj][m][1] * rs;
                    const u32x2 a = pk4_bf16(g * sigm4(g) * up);
                    if (bj == 0) { w.x = a.x; w.y = a.y; } else { w.z = a.x; w.w = a.y; }
                }
                *(u32x4*)(ACT + tixa((size_t)row, 128 * u.pn + 32 * wc + 8 * fq, FH_)) = w;
            }
    }
};

struct ConvD { const float* s0; const float* s1; const float* gain; bf16_t* dst; int ld0, ld1, inter, K, rt, k0, kperm; };
__device__ __forceinline__ ConvD conv_decode(const Params& p, int item) {
    ConvD d; d.s0 = nullptr; d.s1 = nullptr; d.gain = nullptr; d.ld0 = 0; d.ld1 = 0; d.inter = 0; d.kperm = 0;
    const int l = item / 7552; int it = item % 7552; int kt; size_t doff;
    if (it < 2304) {
        d.rt = it >> 4; kt = it & 15; d.K = 2048; d.kperm = 2; doff = OFF_WIN; d.gain = p.in[1] + l * 2048;
        const float* wl = p.in[4] + (size_t)l * D_ * NIN_;
#pragma unroll
        for (int s = 0; s < 2; ++s) {
            const int sg = 2 * d.rt + s; const float* ptr = nullptr; int ld = NIN_;
            if (sg < 153) ptr = wl + 32 * sg;
            else if (sg == 153) { if (l > 0) { ptr = p.in[17] + (size_t)(l - 1) * D_ * 32; ld = 32; } }
            else if (sg >= 160) ptr = wl + (32 * sg - 224);
            if (s == 0) { d.s0 = ptr; d.ld0 = ld; } else { d.s1 = ptr; d.ld1 = ld; }
        }
    } else if (it < 2560) { it -= 2304; d.rt = it >> 3; kt = it & 7; d.K = 1024; doff = OFF_WBA; d.s0 = p.in[21] + (size_t)l * C_ * D_ + 64 * d.rt; d.s1 = d.s0 + 32; d.ld0 = d.ld1 = D_; }
    else if (it < 2816) { it -= 2560; d.rt = it >> 3; kt = it & 7; d.K = 1024; doff = OFF_WBR; d.s0 = p.in[22] + (size_t)l * C_ * D_ + 64 * d.rt; d.s1 = d.s0 + 32; d.ld0 = d.ld1 = D_; }
    else if (it < 3328) { it -= 2816; d.rt = it >> 4; kt = it & 15; d.K = 2048; d.kperm = 2; doff = OFF_WO; d.s0 = p.in[23] + (size_t)l * D_ * D_ + 64 * d.rt; d.s1 = d.s0 + 32; d.ld0 = d.ld1 = D_; }
    else if (it < 6144) { it -= 3328; d.rt = it >> 4; kt = it & 15; d.K = 2048; d.kperm = 2; doff = OFF_WGU; d.s0 = p.in[24] + (size_t)l * D_ * FH_ + 32 * d.rt; d.s1 = p.in[25] + (size_t)l * D_ * FH_ + 32 * d.rt; d.ld0 = d.ld1 = FH_; d.inter = 1; d.gain = p.in[2] + l * 2048; }
    else { it -= 6144; d.rt = it / 44; kt = it % 44; d.K = 5632; d.kperm = 1; doff = OFF_WD; d.s0 = p.in[26] + (size_t)l * FH_ * D_ + 64 * d.rt; d.s1 = d.s0 + 32; d.ld0 = d.ld1 = D_; }
    d.dst = (bf16_t*)(p.ws + WS_W) + (size_t)l * LSTRIDE + doff; d.k0 = kt * 128;
    return d;
}
__device__ __forceinline__ void conv_load(const ConvD& d, int tid, f32x4 (&v)[4], float (&g)[4]) {
#pragma unroll
    for (int i = 0; i < 4; ++i) {
        const int idx = tid + 512 * i, seg = idx >> 10, rem = idx & 1023, krow = rem >> 3, c4 = rem & 7;
        const float* ptr = seg ? d.s1 : d.s0; const int ld = seg ? d.ld1 : d.ld0;
        v[i] = (f32x4){0.f, 0.f, 0.f, 0.f}; g[i] = 1.0f;
        if (ptr) v[i] = *(const f32x4*)(ptr + (size_t)(d.k0 + krow) * ld + 4 * c4);
        if (d.gain) g[i] = d.gain[d.k0 + krow];
    }
}
__device__ __forceinline__ void conv_store(const ConvD& d, int tid, LAS bf16_t* tile, const f32x4 (&v)[4], const float (&g)[4]) {
#pragma unroll
    for (int i = 0; i < 4; ++i) {
        const int idx = tid + 512 * i, seg = idx >> 10, rem = idx & 1023, krow = rem >> 3, c4 = rem & 7;
        const u32x2 w = pk4_bf16(v[i] * g[i]);
        const int cc = 4 * c4;
        const int r = d.inter ? (32 * (cc >> 4) + 16 * seg + (cc & 15)) : (32 * seg + cc);
        const int kc = d.kperm == 1 ? (32 * ((krow >> 4) & 3) + 8 * ((krow >> 2) & 3) + 4 * (krow >> 6) + (krow & 3))
                     : d.kperm == 2 ? ((krow & ~31) + 8 * ((krow >> 2) & 3) + 4 * ((krow >> 4) & 1) + (krow & 3)) : krow;
        tile[(r + 0) * 136 + kc] = (bf16_t)(w.x & 0xffff); tile[(r + 1) * 136 + kc] = (bf16_t)(w.x >> 16);
        tile[(r + 2) * 136 + kc] = (bf16_t)(w.y & 0xffff); tile[(r + 3) * 136 + kc] = (bf16_t)(w.y >> 16);
    }
    __syncthreads();
#pragma unroll
    for (int i = 0; i < 2; ++i) {
        const int id = tid + 512 * i, blk = id >> 6, within = id & 63, r = 16 * (blk >> 2) + (within >> 2), k = 32 * (blk & 3) + 8 * (within & 3);
        const u32x4 w = *(const LAS u32x4*)(tile + r * 136 + k);
        *(u32x4*)(d.dst + tixa((size_t)(64 * d.rt + r), d.k0 + k, d.K)) = w;
    }
}
constexpr int CV_SLOT = 24, CV_Q = CV_SLOT * 128, CV_REM = 7552 - 2 * CV_Q, CV_P0 = 7552 + 3 * CV_REM;
__device__ __forceinline__ int conv_map(int j, bool p0map) {
    if (!p0map || j < 7552) return j;
    const int jj = j - 7552, L = 1 + jj / CV_REM; return L * 7552 + 2 * CV_Q + jj % CV_REM;
}
__device__ __forceinline__ void conv_run(const Ctx cx, const Params& p, LAS unsigned char* lds, int first, int n, int stride, bool p0map) {
    if (n <= 0) return;
    const int tid = cx.tid;
    f32x4 v[4], nv[4]; float g[4], ng[4];
    ConvD d = conv_decode(p, conv_map(first, p0map));
    conv_load(d, tid, v, g);
    __syncthreads();
#pragma unroll 1
    for (int i = 0; i < n; ++i) {
        ConvD dn = d;
        if (i + 1 < n) { dn = conv_decode(p, conv_map(first + (i + 1) * stride, p0map)); conv_load(dn, tid, nv, ng); }
        conv_store(d, tid, (LAS bf16_t*)lds + (i & 1) * (64 * 136), v, g);
        d = dn;
#pragma unroll
        for (int j = 0; j < 4; ++j) { v[j] = nv[j]; g[j] = ng[j]; }
    }
    __syncthreads();
}
__device__ __forceinline__ void p0_prologue(const Ctx cx, const Params& p, LAS unsigned char* lds) {
    const int tid = cx.tid, G = cx.G, bx = cx.bx, wave = tid >> 6, lane = tid & 63;
    float* SS = (float*)(p.ws + WS_SS);
    {
        const float* x = p.in[0]; bf16_t* XB = (bf16_t*)(p.ws + WS_XB);
        int row = bx * 8 + wave; f32x4 nx[8];
        if (row < M_) {
#pragma unroll
            for (int i = 0; i < 8; ++i) nx[i] = ((const f32x4*)(x + (size_t)row * D_))[lane + 64 * i];
        }
#pragma unroll 1
        for (; row < M_; row += G * 8) {
            f32x4 v[8];
#pragma unroll
            for (int i = 0; i < 8; ++i) v[i] = nx[i];
            if (row + G * 8 < M_) {
#pragma unroll
                for (int i = 0; i < 8; ++i) nx[i] = ((const f32x4*)(x + (size_t)(row + G * 8) * D_))[lane + 64 * i];
            }
            float s = 0.f;
#pragma unroll
            for (int i = 0; i < 8; ++i) { s += dot4(v[i], v[i]);
                const int lc = (lane + 64 * i) * 4, pc = (lc & ~31) + 8 * ((lc >> 2) & 3) + 4 * ((lc >> 4) & 1);
                *(u32x2*)(XB + tixa((size_t)row, pc, D_)) = pk4_bf16(v[i]); }
#pragma unroll
            for (int o = 32; o >= 1; o >>= 1) s += __shfl_xor(s, o);
            if (lane < 32) SS[(size_t)row * 32 + lane] = (lane == 0) ? s : 0.f;
        }
    }
    {
        bf16_t* UPS = (bf16_t*)(p.ws + WS_UPS);
        for (int i = bx * 512 + tid; i < 4 * UPS_L; i += G * 512) {
            const int l = i / UPS_L, r = i % UPS_L, kk_ = r >> 10, ch = r & 1023; float v; int dst;
            if (kk_ < 64) { const int k = kk_; v = p.in[7][((size_t)l * 64 + k) * C_ + ch]; dst = UPS_D + ((ch >> 4) * 2 + (k >> 5)) * 512 + (ch & 15) * 32 + (k & 31); }
            else if (kk_ < 128) { const int k = kk_ - 64; v = p.in[9][((size_t)l * 64 + k) * C_ + ch]; dst = UPS_I + ((ch >> 4) * 2 + (k >> 5)) * 512 + (ch & 15) * 32 + (k & 31); }
            else if (kk_ < 288) { const int k = kk_ - 128; v = p.in[11][((size_t)l * 160 + k) * C_ + ch]; dst = UPS_G + ((ch >> 4) * 5 + (k >> 5)) * 512 + (ch & 15) * 32 + (k & 31); }
            else { const int k = kk_ - 288; v = l > 0 ? p.in[19][((size_t)(l - 1) * 32 + k) * C_ + ch] : 0.f; dst = UPS_V + (ch >> 4) * 512 + (ch & 15) * 32 + k; }
            UPS[(size_t)l * UPS_L + dst] = (bf16_t)(pk_bf16(v, 0.f) & 0xffff);
        }
    }
    if (G == 256) conv_run(cx, p, lds, bx, (CV_P0 - bx + G - 1) / G, G, true);
    else conv_run(cx, p, lds, bx, (4 * 7552 - bx + G - 1) / G, G, false);
}

#define MFMA16(a, b, c) __builtin_amdgcn_mfma_f32_16x16x32_bf16((a), (b), (c), 0, 0, 0)
#define MFMA32(a, b, c) __builtin_amdgcn_mfma_f32_32x32x16_bf16((a), (b), (c), 0, 0, 0)

__device__ __forceinline__ void prep_phase(const Ctx cx, const Params& p, LAS unsigned char* lds, int l) {
    const int tid = cx.tid, wave = tid >> 6, lane = tid & 63, G = cx.G, tl = lane & 15, kq = lane >> 4;
    const float* PRW = (const float*)(p.ws + WS_PRW);
    float* SC = (float*)(p.ws + WS_SCAN);
    float* Wo = SC; bf16_t* SB = (bf16_t*)(SC + ARR); bf16_t* KKo = SB, *BBo = SB + ARR, *KMo = SB + 2 * ARR, *Ro = SB + 3 * ARR, *Vo = SB + 4 * ARR;
    float* VF = (float*)(p.ws + WS_VFIRST); bf16_t* Gb = (bf16_t*)(p.ws + WS_G);
    const bf16_t* UPS = (const bf16_t*)(p.ws + WS_UPS) + (size_t)l * UPS_L;
    const float* tsm = p.in[6] + (size_t)l * 3360;
    const float* vmix = p.in[18] + (size_t)(l > 0 ? l - 1 : 0) * 32;
    const float* dbias = p.in[8] + l * C_; const float* ibias = p.in[10] + l * C_; const float* kkp = p.in[12] + l * C_; const float* kap = p.in[13] + l * C_;
    const float* vbias = p.in[20] + (size_t)(l > 0 ? l - 1 : 0) * C_;
    LAS u32x4* fr = (LAS u32x4*)lds + wave * 640 + lane;
#pragma unroll 1
    for (int task = cx.bx * 8 + wave; task < 2048; task += G * 8) {
        const int tile = task >> 2, quarter = task & 3;
        const int row = tile * 16 + tl; const bool hasprev = (row & 2047) != 0;
        const unsigned po = prw_row(row), ppo = hasprev ? prw_row(row - 1) : po; const float pm = hasprev ? 1.0f : 0.0f;
#pragma unroll 5
        for (int s = 0; s < 10; ++s) {
            u32x4 w = {0u, 0u, 0u, 0u};
            if (s < 9 || l > 0) {
                const int col = 3072 + 32 * s + 8 * kq;
                f32x4 c0 = *(const f32x4*)(PRW + (po + prw_col(col))), c1 = *(const f32x4*)(PRW + (po + prw_col(col + 4)));
                const f32x4 q0 = *(const f32x4*)(PRW + (ppo + prw_col(col))) * pm, q1 = *(const f32x4*)(PRW + (ppo + prw_col(col + 4))) * pm;
                const float* mup = (s < 9) ? (tsm + col) : (vmix + 8 * kq);
                const f32x4 m0 = *(const f32x4*)mup, m1 = *(const f32x4*)(mup + 4);
                c0 = c0 + (q0 - c0) * m0; c1 = c1 + (q1 - c1) * m1;
                if (s < 2) {
#pragma unroll
                    for (int e = 0; e < 4; ++e) { c0[e] = tanh_fast(c0[e]); c1[e] = tanh_fast(c1[e]); }
                } else if (s >= 4 && s < 9) { c0 = sigm4(c0); c1 = sigm4(c1); }
                const u32x2 a = pk4_bf16(c0), b = pk4_bf16(c1); w.x = a.x; w.y = a.y; w.z = b.x; w.w = b.y;
            }
            fr[s * 64] = w;
        }
#pragma unroll 1
        for (int hh = 0; hh < 4; ++hh) {
            const int cb = quarter * 256 + hh * 64;
            float ssq = 0.f;
#pragma unroll
            for (int ct = 0; ct < 4; ++ct) {
                const int c = cb + 16 * ct + 4 * kq;
                f32x4 k = *(const f32x4*)(PRW + (po + prw_col(1024 + c))); const f32x4 kp = *(const f32x4*)(PRW + (ppo + prw_col(1024 + c))) * pm;
                k = k + (kp - k) * *(const f32x4*)(tsm + 1024 + c);
                const f32x4 kk = k * *(const f32x4*)(kkp + c); ssq += dot4(kk, kk);
            }
            ssq += __shfl_xor(ssq, 16); ssq += __shfl_xor(ssq, 32);
            const float inv = 1.0f / fmaxf(sqrtf(ssq), 1e-12f);
            f32x4 xr, xk, xv, xrp, xkp, xvp, xdb, xib, xkk, xka, xvb, xvf, xmr, xmk, xmv; bf16x8 xu[10];
#define PREP_LOAD(ct_) do { const int c_ = cb + 16 * (ct_) + 4 * kq; \
                xr = *(const f32x4*)(PRW + (po + prw_col(c_))); xk = *(const f32x4*)(PRW + (po + prw_col(1024 + c_))); xv = *(const f32x4*)(PRW + (po + prw_col(2048 + c_))); \
                xrp = *(const f32x4*)(PRW + (ppo + prw_col(c_))); xkp = *(const f32x4*)(PRW + (ppo + prw_col(1024 + c_))); xvp = *(const f32x4*)(PRW + (ppo + prw_col(2048 + c_))); \
                xdb = *(const f32x4*)(dbias + c_); xib = *(const f32x4*)(ibias + c_); xkk = *(const f32x4*)(kkp + c_); xka = *(const f32x4*)(kap + c_); \
                xvb = *(const f32x4*)(vbias + c_); xvf = (l > 0) ? *(const f32x4*)(VF + tix(row, c_)) : (f32x4){0.f, 0.f, 0.f, 0.f}; \
                xmr = *(const f32x4*)(tsm + c_); xmk = *(const f32x4*)(tsm + 1024 + c_); xmv = *(const f32x4*)(tsm + 2048 + c_); } while (0)
#define PREP_LOADU(ct_) do { const int t16_ = (cb >> 4) + (ct_); const bf16_t* ub_ = UPS + tl * 32 + 8 * kq; \
                  _Pragma("unroll") for (int s_ = 0; s_ < 2; ++s_) { xu[s_] = *(const bf16x8*)(ub_ + UPS_D + (t16_ * 2 + s_) * 512); xu[2 + s_] = *(const bf16x8*)(ub_ + UPS_I + (t16_ * 2 + s_) * 512); } \
                  _Pragma("unroll") for (int s_ = 0; s_ < 5; ++s_) xu[4 + s_] = *(const bf16x8*)(ub_ + UPS_G + (t16_ * 5 + s_) * 512); \
                  xu[9] = *(const bf16x8*)(ub_ + UPS_V + t16_ * 512); } while (0)
            PREP_LOAD(0); PREP_LOADU(0);
#pragma unroll 1
            for (int ct = 0; ct < 4; ++ct) {
                const int ch0 = cb + 16 * ct;
                f32x4 aw = {0.f, 0.f, 0.f, 0.f}, aa = aw, ag = aw, avv = aw;
#pragma unroll
                for (int s = 0; s < 2; ++s) aw = MFMA16(xu[s], __builtin_bit_cast(bf16x8, fr[s * 64]), aw);
#pragma unroll
                for (int s = 0; s < 2; ++s) aa = MFMA16(xu[2 + s], __builtin_bit_cast(bf16x8, fr[(2 + s) * 64]), aa);
#pragma unroll
                for (int s = 0; s < 5; ++s) ag = MFMA16(xu[4 + s], __builtin_bit_cast(bf16x8, fr[(4 + s) * 64]), ag);
                if (l > 0) avv = MFMA16(xu[9], __builtin_bit_cast(bf16x8, fr[9 * 64]), avv);
                asm volatile("" ::: "memory"); if (ct < 3) PREP_LOADU(ct + 1);
                const int c = ch0 + 4 * kq; const unsigned o = tix(row, c);
                const f32x4 r = xr + (xrp * pm - xr) * xmr, k = xk + (xkp * pm - xk) * xmk; f32x4 v = xv + (xvp * pm - xv) * xmv;
                *(u32x2*)(Ro + o) = pk4_bf16(r);
                const f32x4 sg = sigm4(xdb + aw);
                f32x4 dec;
#pragma unroll
                for (int e = 0; e < 4; ++e) dec[e] = __expf(-0.6065306597126334f * sg[e]);
                *(f32x4*)(Wo + o) = dec;
                const f32x4 a = sigm4(xib + aa);
                if (l > 0) v = v + (xvf - v) * sigm4(xvb + avv);
                else *(f32x4*)(VF + o) = v;
                *(u32x2*)(Vo + o) = pk4_bf16(v);
                const f32x4 kk = k * xkk * inv;
                *(u32x2*)(KKo + o) = pk4_bf16(kk); *(u32x2*)(BBo + o) = pk4_bf16(kk * a);
                const f32x4 km = k * (1.0f + (a - 1.0f) * xka);
                *(u32x2*)(KMo + o) = pk4_bf16(km);
                *(u32x2*)(Gb + o) = pk4_bf16(ag);
                asm volatile("" ::: "memory"); if (ct < 3) PREP_LOAD(ct + 1);
            }
#undef PREP_LOADU
#undef PREP_LOAD
        }
    }
}

__device__ __forceinline__ bf16x8 pack8(const f32x16& x, const int s) {
    u32x4 w; w.x = pk_bf16(x[8 * s], x[8 * s + 1]); w.y = pk_bf16(x[8 * s + 2], x[8 * s + 3]); w.z = pk_bf16(x[8 * s + 4], x[8 * s + 5]); w.w = pk_bf16(x[8 * s + 6], x[8 * s + 7]);
    return __builtin_bit_cast(bf16x8, w);
}
__device__ __forceinline__ void attn_task(const Params& p, int l, int task, int lane) {
    const bf16_t* QB = (const bf16_t*)(p.ws + WS_QB); const bf16_t* KB = (const bf16_t*)(p.ws + WS_KB); const bf16_t* VT = (const bf16_t*)(p.ws + WS_VT); bf16_t* YA = (bf16_t*)(p.ws + WS_YA);
    const int qt = task & 63, head = (task >> 6) & 15, b = task >> 10;
    const int c = lane & 31, h = lane >> 5, kvh = head >> 2;
    const float slope = exp2f(-0.5f * (float)(head + 1)); const float sink = p.in[5][l * 16 + head];
    const int q0 = qt * 32; const size_t rb = (size_t)b * T_;
    bf16x8 qf[4];
#pragma unroll
    for (int dd = 0; dd < 4; ++dd) qf[dd] = *(const bf16x8*)(QB + (rb + q0 + c) * 1024 + head * 64 + 16 * dd + 8 * h);
    f32x16 S[5];
#pragma unroll
    for (int kt = 0; kt < 5; ++kt) {
        const int key = q0 - 128 + 32 * kt + c, keyc = key < 0 ? 0 : key;
        f32x16 acc;
#pragma unroll
        for (int e = 0; e < 16; ++e) acc[e] = 0.f;
#pragma unroll
        for (int dd = 0; dd < 4; ++dd) acc = MFMA32(*(const bf16x8*)(KB + ((size_t)((b * 4 + kvh) * 4 + dd) * 2048 + keyc) * 16 + 8 * h), qf[dd], acc);
        S[kt] = acc;
    }
    const int t = q0 + c; float mx = sink;
#pragma unroll
    for (int kt = 0; kt < 5; ++kt)
#pragma unroll
        for (int e = 0; e < 16; ++e) {
            const int s = q0 - 128 + 32 * kt + (e & 3) + 8 * (e >> 2) + 4 * h, dist = t - s;
            const bool valid = (dist >= 0) && (dist < 128) && (s >= 0);
            const float val = valid ? (S[kt][e] * 0.125f - slope * (float)dist) : -INFINITY;
            S[kt][e] = val; mx = fmaxf(mx, val);
        }
    mx = fmaxf(mx, __shfl_xor(mx, 32));
    float sum = 0.f;
#pragma unroll
    for (int kt = 0; kt < 5; ++kt)
#pragma unroll
        for (int e = 0; e < 16; ++e) { const float pv = __expf(S[kt][e] - mx); S[kt][e] = pv; sum += pv; }
    sum += __shfl_xor(sum, 32);
    const float inv = 1.0f / (sum + __expf(sink - mx));
    f32x16 O[2];
#pragma unroll
    for (int e = 0; e < 16; ++e) { O[0][e] = 0.f; O[1][e] = 0.f; }
#pragma unroll
    for (int kt = 0; kt < 5; ++kt)
#pragma unroll
        for (int s = 0; s < 2; ++s) {
            const bf16x8 pf = pack8(S[kt], s);
            const int kb = q0 - 128 + 32 * kt + 16 * s + 4 * h; const int k_lo = kb < 0 ? 0 : kb, k_hi = kb + 8 < 0 ? 0 : kb + 8;
#pragma unroll
            for (int dt = 0; dt < 2; ++dt) {
                const bf16_t* vb = VT + (size_t)(b * 4 + kvh) * (512 * 256) + (32 * dt + c) * 4;
                const u32x2 lo = *(const u32x2*)(vb + (k_lo >> 2) * 256), hi = *(const u32x2*)(vb + (k_hi >> 2) * 256);
                u32x4 w; w.x = lo.x; w.y = lo.y; w.z = hi.x; w.w = hi.y;
                O[dt] = MFMA32(__builtin_bit_cast(bf16x8, w), pf, O[dt]);
            }
        }
#pragma unroll
    for (int dt = 0; dt < 2; ++dt)
#pragma unroll
        for (int g4 = 0; g4 < 4; ++g4) {
            const int d = 32 * dt + 8 * g4 + 4 * h;
            f32x4 v = {O[dt][4 * g4] * inv, O[dt][4 * g4 + 1] * inv, O[dt][4 * g4 + 2] * inv, O[dt][4 * g4 + 3] * inv};
            *(u32x2*)(YA + tixa(rb + q0 + c, head * 64 + d, 1024)) = pk4_bf16(v);
        }
}
__device__ __forceinline__ void attn_phase(const Ctx cx, const Params& p, int l) {
    const int wave = cx.tid >> 6, lane = cx.tid & 63;
    for (int task = cx.bx * 8 + wave; task < 4096; task += cx.G * 8) attn_task(p, l, task, lane);
}

struct AttnT { int b, head, kvh, q0, c, h; float slope, sink; size_t rb; };
__device__ __forceinline__ void at_decode(AttnT& t, const Params& p, int l, int task, int lane) {
    const int qt = task & 63; t.head = (task >> 6) & 15; t.b = task >> 10; t.c = lane & 31; t.h = lane >> 5; t.kvh = t.head >> 2;
    t.slope = exp2f(-0.5f * (float)(t.head + 1)); t.sink = p.in[5][l * 16 + t.head]; t.q0 = qt * 32; t.rb = (size_t)t.b * T_;
}
__device__ __forceinline__ void at_load_q(const Params& p, const AttnT& t, bf16x8 (&qf)[4]) {
    const bf16_t* QB = (const bf16_t*)(p.ws + WS_QB);
#pragma unroll
    for (int dd = 0; dd < 4; ++dd) qf[dd] = *(const bf16x8*)(QB + (t.rb + t.q0 + t.c) * 1024 + t.head * 64 + 16 * dd + 8 * t.h);
}
template <int BASE> __device__ __forceinline__ void at_load_k(const Params& p, const AttnT& t, int kt, u32x4 (&buf)[4]) {
    const bf16_t* KB = (const bf16_t*)(p.ws + WS_KB);
    const int key = t.q0 - 128 + 32 * kt + t.c, keyc = key < 0 ? 0 : key;
#pragma unroll
    for (int dd = 0; dd < 4; ++dd) buf[BASE + dd] = *(const u32x4*)(KB + ((size_t)((t.b * 4 + t.kvh) * 4 + dd) * 2048 + keyc) * 16 + 8 * t.h);
}
template <int BASE> __device__ __forceinline__ void at_qk(const bf16x8 (&qf)[4], const u32x4 (&buf)[4], f32x16& S) {
    f32x16 acc;
#pragma unroll
    for (int e = 0; e < 16; ++e) acc[e] = 0.f;
#pragma unroll
    for (int dd = 0; dd < 4; ++dd) acc = MFMA32(__builtin_bit_cast(bf16x8, buf[BASE + dd]), qf[dd], acc);
    S = acc;
}
__device__ __forceinline__ float at_softmax_a(const AttnT& t, f32x16 (&S)[5]) {
    const int tq = t.q0 + t.c; float mx = t.sink;
#pragma unroll
    for (int kt = 0; kt < 5; ++kt)
#pragma unroll
        for (int e = 0; e < 16; ++e) {
            const int s = t.q0 - 128 + 32 * kt + (e & 3) + 8 * (e >> 2) + 4 * t.h, dist = tq - s;
            const bool valid = (dist >= 0) && (dist < 128) && (s >= 0);
            const float val = valid ? (S[kt][e] * 0.125f - t.slope * (float)dist) : -INFINITY;
            S[kt][e] = val; mx = fmaxf(mx, val);
        }
    return fmaxf(mx, __shfl_xor(mx, 32));
}
__device__ __forceinline__ float at_softmax_b(const AttnT& t, f32x16 (&S)[5], float mx) {
    float sum = 0.f;
#pragma unroll
    for (int kt = 0; kt < 5; ++kt)
#pragma unroll
        for (int e = 0; e < 16; ++e) { const float pv = __expf(S[kt][e] - mx); S[kt][e] = pv; sum += pv; }
    sum += __shfl_xor(sum, 32);
    return 1.0f / (sum + __expf(t.sink - mx));
}
template <int BASE> __device__ __forceinline__ void at_load_v(const Params& p, const AttnT& t, int kt, u32x4 (&buf)[4]) {
    const bf16_t* VT = (const bf16_t*)(p.ws + WS_VT);
#pragma unroll
    for (int s = 0; s < 2; ++s) {
        const int kb = t.q0 - 128 + 32 * kt + 16 * s + 4 * t.h; const int k_lo = kb < 0 ? 0 : kb, k_hi = kb + 8 < 0 ? 0 : kb + 8;
#pragma unroll
        for (int dt = 0; dt < 2; ++dt) {
            const bf16_t* vb = VT + (size_t)(t.b * 4 + t.kvh) * (512 * 256) + (32 * dt + t.c) * 4;
            const u32x2 lo = *(const u32x2*)(vb + (k_lo >> 2) * 256), hi = *(const u32x2*)(vb + (k_hi >> 2) * 256);
            u32x4 w; w.x = lo.x; w.y = lo.y; w.z = hi.x; w.w = hi.y; buf[BASE + 2 * s + dt] = w;
        }
    }
}
template <int BASE> __device__ __forceinline__ void at_pv(const f32x16& Skt, const u32x4 (&buf)[4], f32x16 (&O)[2]) {
#pragma unroll
    for (int s = 0; s < 2; ++s) {
        const bf16x8 pf = pack8(Skt, s);
#pragma unroll
        for (int dt = 0; dt < 2; ++dt) O[dt] = MFMA32(__builtin_bit_cast(bf16x8, buf[BASE + 2 * s + dt]), pf, O[dt]);
    }
}
__device__ __forceinline__ void at_store(const Params& p, const AttnT& t, const f32x16 (&O)[2], float inv) {
    bf16_t* YA = (bf16_t*)(p.ws + WS_YA);
#pragma unroll
    for (int dt = 0; dt < 2; ++dt)
#pragma unroll
        for (int g4 = 0; g4 < 4; ++g4) {
            const int d = 32 * dt + 8 * g4 + 4 * t.h;
            f32x4 v = {O[dt][4 * g4] * inv, O[dt][4 * g4 + 1] * inv, O[dt][4 * g4 + 2] * inv, O[dt][4 * g4 + 3] * inv};
            *(u32x2*)(YA + tixa(t.rb + t.q0 + t.c, t.head * 64 + d, 1024)) = pk4_bf16(v);
        }
}

constexpr int SC_CH = 32, SC_STEP = 336;
__device__ __forceinline__ void scan_phase(const Ctx cx, const Params& p, LAS unsigned char* lds, int l, bool fuse_attn) {
    const int tid = cx.tid, wave = __builtin_amdgcn_readfirstlane(tid >> 6), lane = tid & 63, G = cx.G;
    const float* SC = (const float*)(p.ws + WS_SCAN); float* YRAW = (float*)(p.ws + WS_PRW);
    LAS float* ring = (LAS float*)lds;
    for (int tb = cx.bx; tb < 256; tb += G) {
        const int bh = tb >> 2, q = tb & 3, b = bh >> 4, hd = bh & 15;
        const size_t rowb = (size_t)b * T_; const int cbase = hd * 64;
        __syncthreads();
        if (tid >= 256) {
            int ht = tid - 256; asm volatile("" : "+v"(ht));
            const bf16_t* SBh = (const bf16_t*)(SC + ARR);
            const unsigned gw0 = tix((int)rowb + (ht >> 4), cbase + 4 * (ht & 15)), lw0 = (unsigned)((ht >> 4) * SC_STEP + 64 + 4 * (ht & 15));
            const unsigned gb0 = tix((int)rowb + (ht >> 3), cbase + 8 * (ht & 7)), lb0 = (unsigned)((ht >> 3) * SC_STEP + 8 * (ht & 7));
            unsigned gv, lv;
#define gw(i) (gw0 + (unsigned)(i) * 16384u)
#define lw(i) (lw0 + (unsigned)(i) * (16u * SC_STEP))
#define gb(i) (gb0 + (unsigned)(i) * (unsigned)ARR)
#define lb(i) (lb0 + ((i) == 0 ? 0u : 64u + 64u * (unsigned)(i)))
            { const int j = ht & 63, step = j >> 1, c8 = j & 1; gv = 4u * (unsigned)ARR + tix((int)rowb + step, cbase + 16 * q + 8 * c8); lv = (unsigned)(step * SC_STEP + 320 + 8 * c8); }
            const bool hasv = ht < 64;
            f32x4 tw[2]; u32x4 tb[4], tv = {0u, 0u, 0u, 0u};
#define SCAN_LOAD(cofs_) do { _Pragma("unroll") for (int i = 0; i < 2; ++i) tw[i] = *(const f32x4*)(SC + (size_t)(gw(i) + (cofs_))); \
                _Pragma("unroll") for (int i = 0; i < 4; ++i) tb[i] = *(const u32x4*)(SBh + (size_t)(gb(i) + (cofs_))); \
                if (hasv) tv = *(const u32x4*)(SBh + (size_t)(gv + (cofs_))); } while (0)
#define SCAN_PUT8(dst_, w_) do { f32x4 lo_, hi_; lo_[0] = __uint_as_float((w_).x << 16); lo_[1] = __uint_as_float((w_).x & 0xffff0000u); lo_[2] = __uint_as_float((w_).y << 16); lo_[3] = __uint_as_float((w_).y & 0xffff0000u); \
                hi_[0] = __uint_as_float((w_).z << 16); hi_[1] = __uint_as_float((w_).z & 0xffff0000u); hi_[2] = __uint_as_float((w_).w << 16); hi_[3] = __uint_as_float((w_).w & 0xffff0000u); \
                *(LAS f32x4*)(dst_) = lo_; *(LAS f32x4*)((dst_) + 4) = hi_; } while (0)
#define SCAN_STORE(buf_) do { _Pragma("unroll") for (int i = 0; i < 2; ++i) *(LAS f32x4*)((buf_) + lw(i)) = tw[i]; \
                _Pragma("unroll") for (int i = 0; i < 4; ++i) SCAN_PUT8((buf_) + lb(i), tb[i]); \
                if (hasv) SCAN_PUT8((buf_) + lv, tv); } while (0)
            SCAN_LOAD(0u);
            SCAN_STORE(ring);
            SCAN_LOAD((unsigned)SC_CH * C_);
            __syncthreads();
#define SCAN_HB(c_) do { const int cc_ = (c_); if (cc_ < T_ / SC_CH) { LAS float* hb_ = ring + (cc_ & 1) * SC_CH * SC_STEP; SCAN_STORE(hb_); \
                if (cc_ + 1 < T_ / SC_CH) { const unsigned cofs_ = (unsigned)(cc_ + 1) * SC_CH * C_; SCAN_LOAD(cofs_); } } __syncthreads(); } while (0)
            const int hwid = cx.bx * 4 + (wave - 4);
            const bool act = fuse_attn;
#pragma unroll 1
            for (int grp = 0; grp < 4; ++grp) {
                const int cb = 1 + grp * 16;
                AttnT at; bf16x8 qf[4]; u32x4 ab[4]; f32x16 S[5]; f32x16 O[2]; float inv = 0.f, mx = 0.f;
                int task_ = grp * 1024 + hwid; asm volatile("" : "+s"(task_));
                int ln_ = lane; asm volatile("" : "+v"(ln_));
                if (act) { at_decode(at, p, l, task_, ln_); at_load_q(p, at, qf); at_load_k<0>(p, at, 0, ab); }
                SCAN_HB(cb + 0);
                if (act) { at_qk<0>(qf, ab, S[0]); at_load_k<0>(p, at, 1, ab); }
                SCAN_HB(cb + 1);
                if (act) { at_qk<0>(qf, ab, S[1]); at_load_k<0>(p, at, 2, ab); }
                SCAN_HB(cb + 2);
                if (act) { at_qk<0>(qf, ab, S[2]); at_load_k<0>(p, at, 3, ab); }
                SCAN_HB(cb + 3);
                if (act) { at_qk<0>(qf, ab, S[3]); at_load_k<0>(p, at, 4, ab); }
                SCAN_HB(cb + 4);
                if (act) { at_qk<0>(qf, ab, S[4]); }
                SCAN_HB(cb + 5);
                if (act) { mx = at_softmax_a(at, S); }
                SCAN_HB(cb + 6);
                if (act) { inv = at_softmax_b(at, S, mx); at_load_v<0>(p, at, 0, ab); }
                SCAN_HB(cb + 7);
                if (act) {
#pragma unroll
                    for (int e = 0; e < 16; ++e) { O[0][e] = 0.f; O[1][e] = 0.f; }
                    at_pv<0>(S[0], ab, O); at_load_v<0>(p, at, 1, ab); }
                SCAN_HB(cb + 8);
                if (act) { at_pv<0>(S[1], ab, O); at_load_v<0>(p, at, 2, ab); }
                SCAN_HB(cb + 9);
                if (act) { at_pv<0>(S[2], ab, O); at_load_v<0>(p, at, 3, ab); }
                SCAN_HB(cb + 10);
                if (act) { at_pv<0>(S[3], ab, O); at_load_v<0>(p, at, 4, ab); }
                SCAN_HB(cb + 11);
                if (act) { at_pv<0>(S[4], ab, O); at_store(p, at, O, inv); }
                SCAN_HB(cb + 12);
                SCAN_HB(cb + 13);
                SCAN_HB(cb + 14);
                SCAN_HB(cb + 15);
            }
#undef SCAN_HB
#undef gw
#undef lw
#undef gb
#undef lb
#undef SCAN_LOAD
#undef SCAN_PUT8
#undef SCAN_STORE
        } else {
            int lane_s = lane; asm volatile("" : "+v"(lane_s));
            const int jg = lane_s & 15, ri = lane_s >> 4;
            f32x2 Sa = {0.f, 0.f}, Sb = {0.f, 0.f};
            __builtin_amdgcn_s_setprio(3);
            __syncthreads();
            for (int c = 0; c < T_ / SC_CH; ++c) {
                const LAS float* base = ring + (c & 1) * SC_CH * SC_STEP;
                float* yp = YRAW + tix((int)rowb + c * SC_CH + jg, cbase + 16 * q + 4 * wave + ri);
                const LAS float* lp = base + 4 * jg; const LAS float* vp = base + 320 + 4 * wave + ri;
                f32x4 kk = *(const LAS f32x4*)(lp), w = *(const LAS f32x4*)(lp + 64), bb = *(const LAS f32x4*)(lp + 128), km = *(const LAS f32x4*)(lp + 192), r = *(const LAS f32x4*)(lp + 256);
                float v = vp[0];
#pragma unroll 1
                for (int g16 = 0; g16 < SC_CH / 16; ++g16) {
                    float ykeep = 0.f;
#pragma unroll
                    for (int s16 = 0; s16 < 16; ++s16) {
                        f32x4 nkk = kk, nw = w, nbb = bb, nkm = km, nr = r; float nv = v;
                        if (s16 < 15 || g16 + 1 < SC_CH / 16) {
                            const LAS float* np = lp + (g16 * 16 + s16 + 1) * SC_STEP;
                            nkk = *(const LAS f32x4*)(np); nw = *(const LAS f32x4*)(np + 64); nbb = *(const LAS f32x4*)(np + 128); nkm = *(const LAS f32x4*)(np + 192); nr = *(const LAS f32x4*)(np + 256);
                            nv = vp[(g16 * 16 + s16 + 1) * SC_STEP];
                        }
                        const f32x2 dd = Sa * kk.xy + Sb * kk.zw;
                        const float d = red16(dd.x + dd.y);
                        const f32x2 ta = km.xy * v - bb.xy * d, tb2 = km.zw * v - bb.zw * d;
                        Sa = Sa * w.xy + ta; Sb = Sb * w.zw + tb2;
                        const f32x2 yy = Sa * r.xy + Sb * r.zw;
                        const float y = red16(yy.x + yy.y);
                        ykeep = (jg == s16) ? y : ykeep;
                        kk = nkk; w = nw; bb = nbb; km = nkm; r = nr; v = nv;
                    }
                    yp[g16 * 16384] = ykeep;
                }
                __syncthreads();
            }
            __builtin_amdgcn_s_setprio(0);
        }
    }
}

__device__ __forceinline__ void post_phase(const Ctx cx, const Params& p, int l) {
    const int wave = cx.tid >> 6, lane = cx.tid & 63, jg = lane & 15;
    const float* YRAW = (const float*)(p.ws + WS_PRW); const float* SC = (const float*)(p.ws + WS_SCAN);
    const bf16_t* SB = (const bf16_t*)(SC + ARR); const bf16_t* KMi = SB + 2 * ARR, *Ri = SB + 3 * ARR, *Vi = SB + 4 * ARR; const bf16_t* Gb = (const bf16_t*)(p.ws + WS_G); bf16_t* YR = (bf16_t*)(p.ws + WS_YR);
    const float* rk = p.in[14] + l * C_; const float* lw = p.in[15] + l * C_; const float* lb = p.in[16] + l * C_;
    const int NIT = M_ * 16 / 4, stride = cx.G * 8;
    int it = cx.bx * 8 + wave;
    f32x4 ny = {0.f, 0.f, 0.f, 0.f}; u32x2 nr = {0u, 0u}, nkm = nr, nv = nr, ng = nr;
#define POST_LOAD(it_) do { const int row_ = ((it_) >> 4) * 4 + (lane >> 4), c_ = ((it_) & 15) * 64 + 4 * jg; const unsigned o_ = tix(row_, c_); \
        ny = *(const f32x4*)(YRAW + o_); nr = *(const u32x2*)(Ri + o_); nkm = *(const u32x2*)(KMi + o_); nv = *(const u32x2*)(Vi + o_); ng = *(const u32x2*)(Gb + o_); } while (0)
    if (it < NIT) POST_LOAD(it);
#pragma unroll 1
    for (; it < NIT; it += stride) {
        const int row = (it >> 4) * 4 + (lane >> 4), hd = it & 15, c = hd * 64 + 4 * jg;
        const f32x4 y = ny; const u32x2 pr_ = nr, pkm = nkm, pv_ = nv, pg = ng;
        if (it + stride < NIT) POST_LOAD(it + stride);
        const f32x4 rkc = *(const f32x4*)(rk + c), lwc = *(const f32x4*)(lw + c), lbc = *(const f32x4*)(lb + c);
        const float mean = red16((y[0] + y[1]) + (y[2] + y[3])) * (1.0f / 64.0f);
        const f32x4 d = y - mean; const float var = red16(dot4(d, d)) * (1.0f / 64.0f); const float rstd = rsqrtf(var + LNX_EPS);
        const f32x4 r = unpk4_bf16(pr_), km = unpk4_bf16(pkm), v = unpk4_bf16(pv_), g = unpk4_bf16(pg);
        const float bonus = red16(dot4(r * km, rkc));
        const f32x4 outv = ((d * rstd) * lwc + lbc + bonus * v) * g;
        *(u32x2*)(YR + tixa((size_t)row, c, 1024)) = pk4_bf16(outv);
    }
#undef POST_LOAD
}

__device__ __forceinline__ void final_phase(const Ctx cx, const Params& p) {
    const bf16_t* XB = (const bf16_t*)(p.ws + WS_XB); const float* ss = (const float*)(p.ws + WS_SS) + (size_t)8 * M_ * 32; const float* g = p.in[3];
    const int wave = cx.tid >> 6, lane = cx.tid & 63, stride = cx.G * 8;
    int row = cx.bx * 8 + wave; u32x2 nx[8]; float nsq = 0.f;
    f32x4 gv[8]; int pc[8];
#pragma unroll
    for (int i = 0; i < 8; ++i) { const int lc = (lane + 64 * i) * 4; gv[i] = *(const f32x4*)(g + lc); pc[i] = (lc & ~31) + 8 * ((lc >> 2) & 3) + 4 * ((lc >> 4) & 1); }
    if (row < M_) { nsq = ss[(size_t)row * 32 + (lane & 31)];
#pragma unroll
        for (int i = 0; i < 8; ++i) nx[i] = *(const u32x2*)(XB + tixa((size_t)row, pc[i], D_)); }
#pragma unroll 1
    for (; row < M_; row += stride) {
        u32x2 v[8]; float sq = nsq;
#pragma unroll
        for (int i = 0; i < 8; ++i) v[i] = nx[i];
        if (row + stride < M_) { nsq = ss[(size_t)(row + stride) * 32 + (lane & 31)];
#pragma unroll
            for (int i = 0; i < 8; ++i) nx[i] = *(const u32x2*)(XB + tixa((size_t)(row + stride), pc[i], D_)); }
#pragma unroll
        for (int o = 16; o >= 1; o >>= 1) sq += __shfl_xor(sq, o);
        const float rs = rsqrtf(sq * (1.0f / 2048.0f) + NORM_EPS);
        f32x4* orow = (f32x4*)(p.out + (size_t)row * D_);
#pragma unroll
        for (int i = 0; i < 8; ++i) orow[lane + 64 * i] = unpk4_bf16(v[i]) * rs * gv[i];
    }
}

#define XB_TMO      128
#define XB_XCNT(j)  (256  + 64 * (j))
#define XB_XSUB(j)  (1280 + 64 * (j))
#define XB_XGEN(j)  (2304 + 64 * (j))
#define XB_TOP      3328
#define XB_TOPGEN   3392
#define XCD_BAR_WORDS 3456
#define XB_SPIN_CAP (1u << 20)
__device__ __forceinline__ unsigned xb_ld(unsigned* p)              { return __hip_atomic_load(p, __ATOMIC_RELAXED, __HIP_MEMORY_SCOPE_AGENT); }
__device__ __forceinline__ unsigned xb_add(unsigned* p, unsigned v) { return __hip_atomic_fetch_add(p, v, __ATOMIC_RELAXED, __HIP_MEMORY_SCOPE_AGENT); }
__device__ __forceinline__ unsigned xb_xcc_id() { return (unsigned)__builtin_amdgcn_s_getreg((3 << 11) | 20) & 0xFu; }
#define XB_SPIN(cond, bar) do { unsigned _sp = 0; while (cond) { __builtin_amdgcn_s_sleep(1); \
    if ((++_sp & 255u) == 0u) { if (xb_ld(&(bar)[XB_TMO])) break; if (_sp > XB_SPIN_CAP) { atomicAdd(&(bar)[XB_TMO], 1u); break; } } } } while (0)
struct XcdBarrier { unsigned* bar; unsigned x; volatile LAS unsigned* st; };
__device__ __forceinline__ XcdBarrier xcd_barrier_post(unsigned* bar, volatile LAS unsigned* st, bool leader) {
    XcdBarrier b; b.bar = bar; b.x = xb_xcc_id(); b.st = st;
    if (leader) (void)xb_add(&bar[XB_XCNT(b.x)], 1u);
    return b;
}
__device__ __forceinline__ void xcd_barrier_complete(unsigned* bar, unsigned x, unsigned& nloc, unsigned& nx) {
    const unsigned G = gridDim.x * gridDim.y * gridDim.z;
    unsigned sum, cnt, mine, sp = 0u;
    for (;;) {
        sum = 0u; cnt = 0u; mine = 0u;
#pragma unroll
        for (unsigned j = 0; j < 16; ++j) { const unsigned c = xb_ld(&bar[XB_XCNT(j)]); sum += c; cnt += (c > 0u) ? 1u : 0u; mine = (j == x) ? c : mine; }
        if (sum == G) break;
        __builtin_amdgcn_s_sleep(1);
        if ((++sp & 255u) == 0u) { if (xb_ld(&bar[XB_TMO])) break; if (sp > XB_SPIN_CAP) { atomicAdd(&bar[XB_TMO], 1u); break; } }
    }
    nloc = mine > 0u ? mine : 1u; nx = cnt > 0u ? cnt : 1u;
}
__device__ __forceinline__ void xcd_barrier(const XcdBarrier& b, bool leader) {
    asm volatile("s_waitcnt vmcnt(0)" ::: "memory");
    __syncthreads();
    if (leader) {
        unsigned* bar = b.bar;
        __builtin_amdgcn_s_waitcnt(0);
        unsigned nloc = b.st[0], nx = b.st[1];
        if (nloc == 0u) { xcd_barrier_complete(bar, b.x, nloc, nx); b.st[0] = nloc; b.st[1] = nx; }
        const unsigned old = xb_add(&bar[XB_XSUB(b.x)], 1u);
        const unsigned gen = old / nloc;
        if (old + 1u == (gen + 1u) * nloc) {
            __builtin_amdgcn_fence(__ATOMIC_RELEASE, "agent");
            asm volatile("s_waitcnt vmcnt(0)" ::: "memory");
            const unsigned og = xb_add(&bar[XB_TOP], 1u);
            const unsigned tg = og / nx;
            if (og + 1u == (tg + 1u) * nx) xb_add(&bar[XB_TOPGEN], 1u);
            else XB_SPIN(xb_ld(&bar[XB_TOPGEN]) == tg, bar);
            __builtin_amdgcn_fence(__ATOMIC_ACQUIRE, "agent");
            xb_add(&bar[XB_XGEN(b.x)], 1u);
            asm volatile("s_waitcnt vmcnt(0)" ::: "memory");
        } else {
            XB_SPIN(xb_ld(&bar[XB_XGEN(b.x)]) == gen, bar);
            __builtin_amdgcn_fence(__ATOMIC_ACQUIRE, "agent");
            asm volatile("s_waitcnt vmcnt(0)" ::: "memory");
        }
    }
    __syncthreads();
}

constexpr int N_PHASES = 34;
__global__ void __launch_bounds__(512, 2) fwd_kernel(Params p_arg) {
    extern __shared__ __attribute__((aligned(16))) unsigned char smem[];
    LAS unsigned char* lds = (LAS unsigned char*)smem;
    cg::grid_group grid = cg::this_grid();
    const int ph_lo = p_arg.ph_lo, ph_hi = p_arg.ph_hi;
    volatile LAS unsigned* bst = (volatile LAS unsigned*)(lds + LDS_STAGE);
    const int wave_id_ = __builtin_amdgcn_readfirstlane((int)threadIdx.x >> 6);
    if (threadIdx.x == 0) { bst[0] = 0u; bst[1] = 0u; }
    __syncthreads();
    XcdBarrier xbar; xbar.bar = (unsigned*)(p_arg.ws + WS_BAR); xbar.x = 0; xbar.st = bst;
    if (ph_hi - ph_lo > 1) xbar = xcd_barrier_post((unsigned*)(p_arg.ws + WS_BAR), bst, threadIdx.x == 0);
    for (int ph = ph_lo; ph < ph_hi; ++ph) {
        if (ph > ph_lo) { if (ph_lo < 0) grid.sync(); else { int l0_; asm volatile("v_mbcnt_lo_u32_b32 %0, -1, 0\n\tv_mbcnt_hi_u32_b32 %0, -1, %0" : "=v"(l0_)); xcd_barrier(xbar, wave_id_ == 0 && l0_ == 0); } }
        Ctx cx; { int ln_; asm volatile("v_mbcnt_lo_u32_b32 %0, -1, 0\n\tv_mbcnt_hi_u32_b32 %0, -1, %0" : "=v"(ln_));
        int t_ = wave_id_ * 64 + ln_, b_ = blockIdx.x, g_ = gridDim.x; asm volatile("" : "+v"(t_)); asm volatile("" : "+s"(b_)); asm volatile("" : "+s"(g_)); cx.tid = t_; cx.bx = b_; cx.G = g_; }
        const Params& p = p_arg;
        const int G = cx.G, bx = cx.bx;
        unsigned char* ws = p.ws;
        const bf16_t* XB = (const bf16_t*)(ws + WS_XB); float* SS = (float*)(ws + WS_SS); float* XRES = (float*)(ws + WS_XRES);
        if (ph == 0) { for (int r_ = 0; r_ < REP_P0; ++r_) p0_prologue(cx, p, lds); continue; }
        if (ph == N_PHASES - 1) { final_phase(cx, p); continue; }
        const int l = (ph - 1) >> 3, k = (ph - 1) & 7;
        const bf16_t* WL = (const bf16_t*)(ws + WS_W) + (size_t)l * LSTRIDE;
        pg8::StaticOrder S;
        if (k == 0) {
            pg8::Gemm g{XB, WL + OFF_WIN, M_, NP_, D_}; S.init(M_, NP_, G, bx);
            rs_table_fill(cx, lds, S, SS + (size_t)(2 * l) * M_ * 32);
            EpiInProj E{(const LAS float*)(lds + LDS_RST), (bf16_t*)(ws + WS_QB), (bf16_t*)(ws + WS_KB), (bf16_t*)(ws + WS_VT), (float*)(ws + WS_PRW), (bf16_t*)(ws + WS_SG)};
            for (int r_ = 0; r_ < REP_INPROJ; ++r_) pg8::gemm_phase(cx, lds, g, S, E);
            if (G == 256 && bx >= 128 && l < 3) conv_run(cx, p, lds, (l + 1) * 7552 + (bx - 128), CV_SLOT, 128, false);
        } else if (k == 1) { for (int r_ = 0; r_ < REP_PREP; ++r_) prep_phase(cx, p, lds, l); if (G != 256) attn_phase(cx, p, l); }
        else if (k == 2) { for (int r_ = 0; r_ < REP_SCAN; ++r_) scan_phase(cx, p, lds, l, G == 256); }
        else if (k == 3) { for (int r_ = 0; r_ < REP_POST; ++r_) post_phase(cx, p, l); }
        else if (k == 4) {
            pg8::PairOrder SP; SP.init(M_, D_, G, bx);
            pg8::Gemm g{(const bf16_t*)(ws + WS_YA), WL + OFF_WBA, 2 * M_, 2 * D_, C_};
            EpiBranchPair E{(const bf16_t*)(ws + WS_SG), (bf16_t*)(ws + WS_MRG)};
            pg8::gemm_phase(cx, lds, g, SP, E);
        } else if (k == 5) {
            pg8::Gemm g{(const bf16_t*)(ws + WS_MRG), WL + OFF_WO, M_, D_, D_}; S.init(M_, D_, G, bx);
            EpiResid E{(bf16_t*)(ws + WS_XB), SS + (size_t)(2 * l + 1) * M_ * 32};
            pg8::gemm_phase(cx, lds, g, S, E);
        } else if (k == 6) {
            pg8::Gemm g{XB, WL + OFF_WGU, M_, 2 * FH_, D_}; S.init(M_, 2 * FH_, G, bx);
            rs_table_fill(cx, lds, S, SS + (size_t)(2 * l + 1) * M_ * 32);
            EpiFFN E{(const LAS float*)(lds + LDS_RST), (bf16_t*)(ws + WS_PRW)};
            for (int r_ = 0; r_ < REP_GU; ++r_) pg8::gemm_phase(cx, lds, g, S, E);
            if (G == 256 && bx >= 128 && l < 3) conv_run(cx, p, lds, (l + 1) * 7552 + CV_Q + (bx - 128), CV_SLOT, 128, false);
        } else {
            pg8::Gemm g{(const bf16_t*)(ws + WS_PRW), WL + OFF_WD, M_, D_, FH_}; S.init(M_, D_, G, bx);
            EpiResid E{(bf16_t*)(ws + WS_XB), SS + (size_t)(2 * l + 2) * M_ * 32};
            pg8::gemm_phase(cx, lds, g, S, E);
        }
    }
}

extern "C" void kernel_launch(void* const* d_in, const int* in_sizes, int n_in, void* d_out, int out_size, void* d_ws, size_t ws_size, hipStream_t stream) {
    static int grid_blocks = 0;
    if (!grid_blocks) {
        if (n_in != 27 || ws_size < WS_END) { fprintf(stderr, "kernel_launch: unexpected n_in %d / ws_size %zu (need %zu)\n", n_in, ws_size, (size_t)WS_END); grid_blocks = -1; return; }
        int dev = 0, cus = 0, per_cu = 0;
        hipGetDevice(&dev);
        hipDeviceGetAttribute(&cus, hipDeviceAttributeMultiprocessorCount, dev);
        if (hipFuncSetAttribute((const void*)fwd_kernel, hipFuncAttributeMaxDynamicSharedMemorySize, LDS_BYTES) != hipSuccess) { fprintf(stderr, "kernel_launch: hipFuncSetAttribute failed\n"); grid_blocks = -1; return; }
        hipOccupancyMaxActiveBlocksPerMultiprocessor(&per_cu, (const void*)fwd_kernel, 512, LDS_BYTES);
        if (per_cu < 1) { fprintf(stderr, "kernel_launch: occupancy query says %d blocks per CU\n", per_cu); per_cu = 1; }
        (void)hipGetLastError();
        grid_blocks = cus;
        if (grid_blocks < 236) { fprintf(stderr, "kernel_launch: %d CUs: the per-phase rstd table holds 6 units per workgroup (needs >= 236 workgroups)\n", cus); grid_blocks = -1; return; }
    }
    if (grid_blocks < 0) return;
    Params p{};
    for (int i = 0; i < 27; ++i) p.in[i] = (const float*)d_in[i];
    p.out = (float*)d_out; p.ws = (unsigned char*)d_ws;
#if FUSED
    p.ph_lo = 0; p.ph_hi = N_PHASES;
    if (hipMemsetAsync((unsigned char*)d_ws + WS_BAR, 0, 16384, stream) != hipSuccess) { fprintf(stderr, "kernel_launch: memset of the barrier words failed\n"); return; }
    void* args[] = {&p};
    hipError_t e = hipLaunchCooperativeKernel((const void*)fwd_kernel, dim3(grid_blocks), dim3(512), args, LDS_BYTES, stream);
    if (e != hipSuccess) fprintf(stderr, "cooperative launch failed: %s (grid %d)\n", hipGetErrorString(e), grid_blocks);
#else
    for (int ph = 0; ph < N_PHASES; ++ph) {
        p.ph_lo = ph; p.ph_hi = ph + 1;
        hipLaunchKernelGGL(fwd_kernel, dim3(grid_blocks), dim3(512), LDS_BYTES, stream, p);
    }
#endif
}
```

```cpp
#include <hip/hip_runtime.h>
#include <hip/hip_cooperative_groups.h>
#include <cstdio>
namespace cg = cooperative_groups;

#ifndef FUSED
#define FUSED 1
#endif

#ifndef REP_P0
#define REP_P0 1
#endif
#ifndef REP_INPROJ
#define REP_INPROJ 1
#endif
#ifndef REP_PREP
#define REP_PREP 1
#endif
#ifndef REP_ATTN
#define REP_ATTN 1
#endif
#ifndef REP_SCAN
#define REP_SCAN 1
#endif
#ifndef REP_POST
#define REP_POST 1
#endif
#ifndef REP_BR
#define REP_BR 1
#endif
#ifndef REP_GU
#define REP_GU 1
#endif

#define LAS __attribute__((address_space(3)))
typedef unsigned short bf16_t;
typedef short bf16x8 __attribute__((ext_vector_type(8)));
typedef float f32x2 __attribute__((ext_vector_type(2)));
typedef float f32x4 __attribute__((ext_vector_type(4)));
typedef float f32x16 __attribute__((ext_vector_type(16)));
typedef unsigned u32x2 __attribute__((ext_vector_type(2)));
typedef unsigned u32x4 __attribute__((ext_vector_type(4)));
typedef __bf16 nbf2 __attribute__((ext_vector_type(2)));

constexpr int M_ = 8192, D_ = 2048, T_ = 2048, C_ = 1024, FH_ = 5632, NP_ = 9216, NIN_ = 8992, PRWW_ = 3584;
constexpr float NORM_EPS = 1e-5f, LNX_EPS = 64e-5f;

constexpr size_t OFF_WIN = 0, OFF_WBA = OFF_WIN + (size_t)NP_ * D_, OFF_WBR = OFF_WBA + (size_t)D_ * C_, OFF_WO = OFF_WBR + (size_t)D_ * C_,
                 OFF_WGU = OFF_WO + (size_t)D_ * D_, OFF_WD = OFF_WGU + (size_t)2 * FH_ * D_, LSTRIDE = OFF_WD + (size_t)D_ * FH_;
constexpr int UPS_L = 1024 * 320;
constexpr int UPS_D = 0, UPS_I = 65536, UPS_G = 131072, UPS_V = 294912;
constexpr size_t ARR = (size_t)M_ * C_;

constexpr size_t WS_W = 0;
constexpr size_t WS_UPS = WS_W + 4 * LSTRIDE * 2;
constexpr size_t WS_XRES = WS_UPS + (size_t)4 * UPS_L * 2;
constexpr size_t WS_XB = WS_XRES + (size_t)M_ * D_ * 4;
constexpr size_t WS_SS = WS_XB + (size_t)M_ * D_ * 2;
constexpr size_t WS_QB = WS_SS + (size_t)9 * M_ * 32 * 4;
constexpr size_t WS_KB = WS_QB + ARR * 2;
constexpr size_t WS_VT = WS_KB + (size_t)M_ * 256 * 2;
constexpr size_t WS_SG = WS_VT + (size_t)M_ * 256 * 2;
constexpr size_t WS_VFIRST = WS_SG + (size_t)M_ * 4096 * 2;
constexpr size_t WS_G = WS_VFIRST + ARR * 4;
constexpr size_t WS_YA = WS_G + ARR * 2;
constexpr size_t WS_YR = WS_YA + ARR * 2;
constexpr size_t WS_MRG = WS_YR + ARR * 2;
constexpr size_t WS_PRW = WS_MRG + (size_t)M_ * D_ * 2;
constexpr size_t WS_SCAN = WS_PRW + (size_t)M_ * PRWW_ * 4;
constexpr size_t WS_BAR = WS_SCAN + 6 * ARR * 4;
constexpr size_t WS_END = WS_BAR + 16384;
static_assert((size_t)M_ * FH_ * 2 <= (size_t)M_ * PRWW_ * 4, "ACT alias");

constexpr int LDS_STAGE = 131072, LDS_RST = LDS_STAGE + 16, LDS_BYTES = LDS_RST + 6 * 1024;

struct Params { const float* in[27]; float* out; unsigned char* ws; int ph_lo, ph_hi; };
struct Ctx { int tid, bx, G; };

__device__ __forceinline__ unsigned pk_bf16(float lo, float hi) { f32x2 v = {lo, hi}; nbf2 b = __builtin_convertvector(v, nbf2); return __builtin_bit_cast(unsigned, b); }
__device__ __forceinline__ u32x2 pk4_bf16(f32x4 v) { u32x2 r; r.x = pk_bf16(v[0], v[1]); r.y = pk_bf16(v[2], v[3]); return r; }
__device__ __forceinline__ f32x4 unpk4_bf16(u32x2 w) { f32x4 r; r[0] = __uint_as_float(w.x << 16); r[1] = __uint_as_float(w.x & 0xffff0000u); r[2] = __uint_as_float(w.y << 16); r[3] = __uint_as_float(w.y & 0xffff0000u); return r; }
__device__ __forceinline__ float sigm(float x) { return __builtin_amdgcn_rcpf(1.0f + __expf(-x)); }
__device__ __forceinline__ float tanh_fast(float x) { return 1.0f - 2.0f * __builtin_amdgcn_rcpf(1.0f + __expf(2.0f * x)); }
__device__ __forceinline__ f32x4 sigm4(f32x4 v) { f32x4 r; r[0] = sigm(v[0]); r[1] = sigm(v[1]); r[2] = sigm(v[2]); r[3] = sigm(v[3]); return r; }
__device__ __forceinline__ float dot4(f32x4 a, f32x4 b) { return (a[0] * b[0] + a[1] * b[1]) + (a[2] * b[2] + a[3] * b[3]); }
__device__ __forceinline__ float dppf(float x, const int ctrl) { return x; }
#define DPP_ADD(x, ctrl) ((x) + __int_as_float(__builtin_amdgcn_update_dpp(0, __float_as_int(x), (ctrl), 0xF, 0xF, false)))
__device__ __forceinline__ float red16(float x) { x = DPP_ADD(x, 0xB1); x = DPP_ADD(x, 0x4E); x = DPP_ADD(x, 0x141); x = DPP_ADD(x, 0x140); return x; }

__device__ __forceinline__ unsigned prw_row(int row) { return (unsigned)(row >> 4) * (unsigned)(PRWW_ * 16) + (unsigned)(row & 15) * 16u; }
__device__ __forceinline__ unsigned prw_col(int col) { return (unsigned)(col >> 4) * 256u + (unsigned)(col & 15); }
__device__ __forceinline__ unsigned tix(int row, int col) { return (unsigned)(row >> 4) * 16384u + (unsigned)(col >> 4) * 256u + (unsigned)(row & 15) * 16u + (unsigned)(col & 15); }
__device__ __forceinline__ size_t tixa(size_t r, int k, int K) { return ((r >> 4) * (size_t)(K >> 5) + (size_t)(k >> 5)) * 512 + (size_t)((int)(r & 15) * 32 + (k & 31)); }
__device__ __forceinline__ float row_ss(const float* ss, int row, int fq) {
    const f32x4 a = *(const f32x4*)(ss + (size_t)row * 32 + fq * 8), b = *(const f32x4*)(ss + (size_t)row * 32 + fq * 8 + 4);
    float s = ((a[0] + a[1]) + (a[2] + a[3])) + ((b[0] + b[1]) + (b[2] + b[3]));
    s += __shfl_xor(s, 16); s += __shfl_xor(s, 32); return s;
}

namespace pg8 {
constexpr int BM = 256, BK = 64, HALF = 128, HTB = HALF * BK * 2, STAGE_BYTES = 8 * HTB, NXCD = 8, WGM = 8;
__device__ __forceinline__ int lds_byte(int r, int c) { const int st = (r >> 4) * 2 + (c >> 5), rr = r & 15, cc = c & 31, ob = rr * 64 + cc * 2; return st * 1024 + (ob ^ (((ob >> 9) & 1) << 5)); }
__device__ __forceinline__ void stage_rc(int b, int& R, int& Cc) { const int st = b / 1024, sb = b % 1024, swz = sb ^ (((sb >> 9) & 1) << 5); R = (st >> 1) * 16 + swz / 64; Cc = (st & 1) * 32 + (swz % 64) / 2; }
struct Unit { int pm, pn, idx; };
struct Gemm { const bf16_t* A; const bf16_t* Bt; int M, N, K; };
struct StaticOrder {
    int nM, nN, nwg, G, c;
    __device__ void init(int M, int N, int G_, int c_) { nM = M / BM; nN = N / BM; nwg = nM * nN; G = G_; c = c_; }
    __device__ bool next(int i, Unit& u) const {
        const long L = (long)i * G + c; if (L >= nwg) return false;
        int wgid = (int)L; { const int q = nwg / NXCD, r = nwg % NXCD, xcd = wgid % NXCD, off = wgid / NXCD; wgid = (xcd < r ? xcd * (q + 1) : r * (q + 1) + (xcd - r) * q) + off; }
        const int nig = WGM * nN, gid = wgid / nig, fm = gid * WGM, gsz = (nM - fm) < WGM ? (nM - fm) : WGM;
        u.pm = fm + ((wgid % nig) % gsz); u.pn = (wgid % nig) / gsz; u.idx = i; return true;
    }
};

struct PairOrder : StaticOrder {
    __device__ bool next(int i, Unit& u) const { if (!StaticOrder::next(i >> 1, u)) return false; if (i & 1) { u.pm += 32; u.pn += 8; } return true; }
};

template <class Epi, class Sched>
__device__ __forceinline__ void gemm_phase(const Ctx cx, LAS unsigned char* lds, const Gemm g, const Sched& S, const Epi& E) {
    const int tid = cx.tid, wid = __builtin_amdgcn_readfirstlane(tid >> 6), lane = tid & 63, wr = wid >> 2, wc = wid & 3, fr = lane & 15, fq = lane >> 4;
    const int K = g.K, nt = K / BK;
    unsigned voffA[2];
#pragma unroll
    for (int i = 0; i < 2; ++i) { int R, Cc; stage_rc(tid * 16 + i * 8192, R, Cc); voffA[i] = (unsigned)(((R >> 4) * (K >> 5) + (Cc >> 5)) * 512 + (R & 15) * 32 + (Cc & 31)) * 2u; }
    const size_t kstep = (size_t)(2 * 512 * 2);
    const size_t hstep = (size_t)HALF * K * 2;
    const size_t tstep = 2 * hstep;
    const unsigned ldsw = (unsigned)wid * 1024u;
    const int aoff = lds_byte(wr * 64 + fr, fq * 8), boff = lds_byte(wc * 32 + fr, fq * 8);
#define PG8_SA(b, h) (((b) * 2 + (h)) * HTB)
#define PG8_SB(b, h) ((4 + (b) * 2 + (h)) * HTB)
#define PG8_STAGE(bufoff, gbase) do { _Pragma("unroll") for (int _i = 0; _i < 2; ++_i) \
        __builtin_amdgcn_global_load_lds((const unsigned*)((const char*)(gbase) + voffA[_i]), (LAS unsigned*)(lds + (bufoff) + ldsw + _i * 8192), 16, 0, 0); } while (0)
#define PG8_LDA(dst, b, h) do { _Pragma("unroll") for (int m = 0; m < 4; ++m) _Pragma("unroll") for (int k = 0; k < 2; ++k) dst[m][k] = *(const LAS bf16x8*)(lds + PG8_SA(b, h) + aoff + m * 2048 + k * 1024); } while (0)
#define PG8_LDB(dst, b, h) do { _Pragma("unroll") for (int n = 0; n < 2; ++n) _Pragma("unroll") for (int k = 0; k < 2; ++k) dst[n][k] = *(const LAS bf16x8*)(lds + PG8_SB(b, h) + boff + n * 2048 + k * 1024); } while (0)
#define PG8_MMA(ai, bj, At, Bt) do { __builtin_amdgcn_s_setprio(1); _Pragma("unroll") for (int m = 0; m < 4; ++m) _Pragma("unroll") for (int n = 0; n < 2; ++n) _Pragma("unroll") for (int k = 0; k < 2; ++k) \
        acc[ai][bj][m][n] = __builtin_amdgcn_mfma_f32_16x16x32_bf16(Bt[n][k], At[m][k], acc[ai][bj][m][n], 0, 0, 0); __builtin_amdgcn_s_setprio(0); } while (0)
#define PG8_WAIT_V(n) asm volatile("s_waitcnt vmcnt(" #n ")" ::: "memory")
#define PG8_WAIT_L(n) asm volatile("s_waitcnt lgkmcnt(" #n ")" ::: "memory")
#define PG8_BAR __builtin_amdgcn_s_barrier()
#define PG8_SCHED __builtin_amdgcn_sched_barrier(0)
    Unit cur, nxt; int ui = 0;
    if (!S.next(0, cur)) return;
    f32x4 acc[2][2][4][2];
#pragma unroll
    for (int a = 0; a < 2; ++a)
#pragma unroll
        for (int b = 0; b < 2; ++b)
#pragma unroll
            for (int m = 0; m < 4; ++m)
#pragma unroll
                for (int n = 0; n < 2; ++n) acc[a][b][m][n] = (f32x4){0.f, 0.f, 0.f, 0.f};
    bf16x8 At[4][2], B0[2][2], B1[2][2];
    const char* cA = (const char*)g.A + (size_t)cur.pm * tstep; const char* cB = (const char*)g.Bt + (size_t)cur.pn * tstep;
    PG8_STAGE(PG8_SB(0, 0), cB); PG8_STAGE(PG8_SA(0, 0), cA); PG8_STAGE(PG8_SB(0, 1), cB + hstep); PG8_STAGE(PG8_SA(0, 1), cA + hstep);
    if (wr == 1) PG8_BAR;
    PG8_WAIT_V(4); PG8_BAR;
    PG8_STAGE(PG8_SB(1, 0), cB + kstep); PG8_STAGE(PG8_SA(1, 0), cA + kstep); PG8_STAGE(PG8_SB(1, 1), cB + hstep + kstep);
    PG8_WAIT_V(6); PG8_BAR;
    for (;;) {
        const bool has_next = S.next(ui + 1, nxt);
        const char* nA = has_next ? (const char*)g.A + (size_t)nxt.pm * tstep : cA; const char* nB = has_next ? (const char*)g.Bt + (size_t)nxt.pn * tstep : cB;
        for (int t = 0; t < nt; t += 2) {
            const bool last = (t == nt - 2);
            const char* a1 = cA + (size_t)(t + 1) * kstep;
            const char* a2 = last ? nA : cA + (size_t)(t + 2) * kstep; const char* b2 = last ? nB : cB + (size_t)(t + 2) * kstep;
            const char* a3 = a2 + kstep; const char* b3 = b2 + kstep;
            PG8_LDB(B0, 0, 0); PG8_SCHED; PG8_LDA(At, 0, 0); PG8_STAGE(PG8_SA(1, 1), a1 + hstep);
            PG8_WAIT_L(8); PG8_BAR; PG8_WAIT_L(0); PG8_MMA(0, 0, At, B0); PG8_BAR; PG8_SCHED;
            PG8_LDB(B1, 0, 1); PG8_STAGE(PG8_SB(0, 0), b2);
            PG8_BAR; PG8_WAIT_L(0); PG8_MMA(0, 1, At, B1); PG8_BAR;
            PG8_LDA(At, 0, 1); PG8_STAGE(PG8_SA(0, 0), a2);
            PG8_BAR; PG8_WAIT_L(0); PG8_MMA(1, 0, At, B0); PG8_BAR; PG8_SCHED;
            PG8_STAGE(PG8_SB(0, 1), b2 + hstep);
            PG8_WAIT_V(6); PG8_BAR; PG8_MMA(1, 1, At, B1); PG8_BAR;
            PG8_LDB(B0, 1, 0); PG8_SCHED; PG8_LDA(At, 1, 0); PG8_STAGE(PG8_SA(0, 1), a2 + hstep);
            PG8_WAIT_L(8); PG8_BAR; PG8_WAIT_L(0); PG8_MMA(0, 0, At, B0); PG8_BAR; PG8_SCHED;
            PG8_LDB(B1, 1, 1); PG8_STAGE(PG8_SB(1, 0), b3);
            PG8_BAR; PG8_WAIT_L(0); PG8_MMA(0, 1, At, B1); PG8_BAR;
            PG8_LDA(At, 1, 1); PG8_STAGE(PG8_SA(1, 0), a3);
            PG8_BAR; PG8_WAIT_L(0); PG8_MMA(1, 0, At, B0); PG8_BAR; PG8_SCHED;
            PG8_STAGE(PG8_SB(1, 1), b3 + hstep);
            PG8_WAIT_V(6); PG8_BAR; PG8_MMA(1, 1, At, B1); PG8_BAR;
        }
        bool keep = false;
        if constexpr (Epi::PAIR) { if (cur.pm < 32) { E.mid(acc, cur, wr, wc, fr, fq); keep = true; } else E(acc, cur, wr, wc, fr, fq); }
        else E(acc, cur, wr, wc, fr, fq);
        if (!has_next) break;
        if (!keep)
#pragma unroll
        for (int a = 0; a < 2; ++a)
#pragma unroll
            for (int b = 0; b < 2; ++b)
#pragma unroll
                for (int m = 0; m < 4; ++m)
#pragma unroll
                    for (int n = 0; n < 2; ++n) acc[a][b][m][n] = (f32x4){0.f, 0.f, 0.f, 0.f};
        cur = nxt; cA = nA; cB = nB; ++ui;
    }
    PG8_WAIT_V(0);
    if (wr == 0) PG8_BAR;
    PG8_BAR;
#undef PG8_SA
#undef PG8_SB
#undef PG8_STAGE
#undef PG8_LDA
#undef PG8_LDB
#undef PG8_MMA
#undef PG8_WAIT_V
#undef PG8_WAIT_L
#undef PG8_BAR
#undef PG8_SCHED
}
}

typedef f32x4 AccT[2][2][4][2];

__device__ __forceinline__ void rs_table_fill(const Ctx cx, LAS unsigned char* lds, const pg8::StaticOrder& S, const float* ss) {
    LAS float* tab = (LAS float*)(lds + LDS_RST);
    const int t = cx.tid & 255, par = cx.tid >> 8;
    float sq[3]; bool ok[3];
#pragma unroll
    for (int k = 0; k < 3; ++k) {
        pg8::Unit u; ok[k] = S.next(2 * k + par, u); sq[k] = 0.f;
        if (ok[k]) { const float* sp = ss + (size_t)(u.pm * 256 + t) * 32;
#pragma unroll
            for (int j = 0; j < 8; ++j) { const f32x4 a = *(const f32x4*)(sp + 4 * j); sq[k] += (a[0] + a[1]) + (a[2] + a[3]); } }
    }
#pragma unroll
    for (int k = 0; k < 3; ++k) if (ok[k]) tab[(2 * k + par) * 256 + t] = rsqrtf(sq[k] * (1.0f / 2048.0f) + NORM_EPS);
    __syncthreads();
}
struct EpiInProj {
    static constexpr bool PAIR = false;
    const LAS float* rst; bf16_t* QB; bf16_t* KB; bf16_t* VT; bf16_t* PRW; bf16_t* SG;
    __device__ __forceinline__ void operator()(const AccT& acc, const pg8::Unit& u, int wr, int wc, int fr, int fq) const {
        const int row0 = u.pm * 256 + wr * 64 + fr, col0 = u.pn * 256 + wc * 32 + 4 * fq; const int pn = u.pn;
#pragma unroll
        for (int ai = 0; ai < 2; ++ai)
#pragma unroll
            for (int m = 0; m < 4; ++m) {
                const int row = row0 + ai * 128 + m * 16; const float rs = rst[u.idx * 256 + (row - u.pm * 256)];
#pragma unroll
                for (int bj = 0; bj < 2; ++bj) {
                    if (pn >= 20) {
                        const u32x2 a = pk4_bf16(sigm4(acc[ai][bj][m][0] * rs)), b = pk4_bf16(sigm4(acc[ai][bj][m][1] * rs));
                        u32x4 w; w.x = a.x; w.y = a.y; w.z = b.x; w.w = b.y;
                        *(u32x4*)(SG + tixa((size_t)row, (pn * 256 + bj * 128 + wc * 32 - 5120) + 8 * fq, 4096)) = w;
                    } else
#pragma unroll
                    for (int n = 0; n < 2; ++n) {
                        const int c = col0 + bj * 128 + n * 16; const f32x4 v = acc[ai][bj][m][n] * rs;
                        if (pn < 4) *(u32x2*)(QB + (size_t)row * 1024 + c) = pk4_bf16(v);
                        else if (pn == 4) { const int cc = c - 1024, kvh = cc >> 6, d = cc & 63, b = row >> 11, t = row & 2047;
                            *(u32x2*)(KB + ((size_t)((b * 4 + kvh) * 4 + (d >> 4)) * 2048 + t) * 16 + (d & 15)) = pk4_bf16(v); }
                        else if (pn == 5) { const int cc = c - 1280, kvh = cc >> 6, d = cc & 63, b = row >> 11, t = row & 2047; bf16_t* vp = VT + ((size_t)(b * 4 + kvh) * 512 + (t >> 2)) * 256 + d * 4 + (t & 3);
                            const u32x2 w = pk4_bf16(v); vp[0] = (bf16_t)(w.x & 0xffff); vp[4] = (bf16_t)(w.x >> 16); vp[8] = (bf16_t)(w.y & 0xffff); vp[12] = (bf16_t)(w.y >> 16); }
                        else *(u32x2*)(PRW + (prw_row(row) + prw_col(c - 1536))) = pk4_bf16(v);
                    }
                }
            }
    }
};
template <int SECOND> struct EpiBranch {
    static constexpr bool PAIR = false;
    const bf16_t* SG; float* MRGF; bf16_t* MRG;
    __device__ __forceinline__ void operator()(const AccT& acc, const pg8::Unit& u, int wr, int wc, int fr, int fq) const {
        const int row0 = u.pm * 256 + wr * 64 + fr, col0 = u.pn * 256 + wc * 32 + 4 * fq;
#pragma unroll
        for (int ai = 0; ai < 2; ++ai)
#pragma unroll
            for (int m = 0; m < 4; ++m) {
                const int row = row0 + ai * 128 + m * 16;
#pragma unroll
                for (int bj = 0; bj < 2; ++bj)
#pragma unroll
                    for (int n = 0; n < 2; ++n) {
                        const int c = col0 + bj * 128 + n * 16;
                        const f32x4 sg = unpk4_bf16(*(const u32x2*)(SG + (size_t)row * 4096 + SECOND * 2048 + c));
                        float* mp = MRGF + (size_t)row * 2048 + c;
                        if (!SECOND) *(f32x4*)mp = sg * acc[ai][bj][m][n];
                        else { const f32x4 o = *(const f32x4*)mp + sg * acc[ai][bj][m][n]; *(u32x2*)(MRG + (size_t)row * 2048 + c) = pk4_bf16(o); }
                    }
            }
    }
};
struct EpiBranchPair {
    static constexpr bool PAIR = true;
    const bf16_t* SG; bf16_t* MRG;
    __device__ __forceinline__ void mid(AccT& acc, const pg8::Unit& u, int wr, int wc, int fr, int fq) const {
        const int row0 = u.pm * 256 + wr * 64 + fr, col0 = u.pn * 256 + wc * 32 + 4 * fq;
#pragma unroll
        for (int ai = 0; ai < 2; ++ai)
#pragma unroll
            for (int m = 0; m < 4; ++m) {
                const int row = row0 + ai * 128 + m * 16;
#pragma unroll
                for (int bj = 0; bj < 2; ++bj) {
                    const int gc = (u.pn * 256 + bj * 128 + wc * 32) + 8 * fq;
                    const u32x4 sa8 = *(const u32x4*)(SG + tixa((size_t)row, gc, 4096)), sb8 = *(const u32x4*)(SG + tixa((size_t)row, 2048 + gc, 4096));
#pragma unroll
                    for (int n = 0; n < 2; ++n) {
                        const f32x4 sa = unpk4_bf16(n ? (u32x2){sa8.z, sa8.w} : (u32x2){sa8.x, sa8.y}), sb = unpk4_bf16(n ? (u32x2){sb8.z, sb8.w} : (u32x2){sb8.x, sb8.y});
                        f32x4 q; q[0] = sa[0] * __builtin_amdgcn_rcpf(sb[0]); q[1] = sa[1] * __builtin_amdgcn_rcpf(sb[1]); q[2] = sa[2] * __builtin_amdgcn_rcpf(sb[2]); q[3] = sa[3] * __builtin_amdgcn_rcpf(sb[3]);
                        acc[ai][bj][m][n] = acc[ai][bj][m][n] * q;
                    }
                }
            }
    }
    __device__ __forceinline__ void operator()(const AccT& acc, const pg8::Unit& u, int wr, int wc, int fr, int fq) const {
        const int row0 = (u.pm - 32) * 256 + wr * 64 + fr, col0 = (u.pn - 8) * 256 + wc * 32 + 4 * fq;
#pragma unroll
        for (int ai = 0; ai < 2; ++ai)
#pragma unroll
            for (int m = 0; m < 4; ++m) {
                const int row = row0 + ai * 128 + m * 16;
#pragma unroll
                for (int bj = 0; bj < 2; ++bj) {
                    const u32x4 sb8 = *(const u32x4*)(SG + tixa((size_t)row, 2048 + ((u.pn - 8) * 256 + bj * 128 + wc * 32) + 8 * fq, 4096));
                    const u32x2 m0 = pk4_bf16(acc[ai][bj][m][0] * unpk4_bf16((u32x2){sb8.x, sb8.y})), m1 = pk4_bf16(acc[ai][bj][m][1] * unpk4_bf16((u32x2){sb8.z, sb8.w}));
                    u32x4 w; w.x = m0.x; w.y = m0.y; w.z = m1.x; w.w = m1.y;
                    *(u32x4*)(MRG + tixa((size_t)row, ((u.pn - 8) * 256 + bj * 128 + wc * 32) + 8 * fq, 2048)) = w;
                }
            }
    }
};
struct EpiResid {
    static constexpr bool PAIR = false;
    bf16_t* XB; float* ssn;
    __device__ __forceinline__ void operator()(const AccT& acc, const pg8::Unit& u, int wr, int wc, int fr, int fq) const {
        const int row0 = u.pm * 256 + wr * 64 + fr;
#pragma unroll
        for (int ai = 0; ai < 2; ++ai)
#pragma unroll
            for (int m = 0; m < 4; ++m) {
                const int row = row0 + ai * 128 + m * 16; float s = 0.f;
#pragma unroll
                for (int bj = 0; bj < 2; ++bj) {
                    bf16_t* xp = XB + tixa((size_t)row, (u.pn * 256 + bj * 128 + wc * 32) + 8 * fq, 2048);
                    const u32x4 b8 = *(const u32x4*)xp;
                    const f32x4 x0 = unpk4_bf16((u32x2){b8.x, b8.y}) + acc[ai][bj][m][0], x1 = unpk4_bf16((u32x2){b8.z, b8.w}) + acc[ai][bj][m][1];
                    s += dot4(x0, x0) + dot4(x1, x1);
                    const u32x2 p0 = pk4_bf16(x0), p1 = pk4_bf16(x1);
                    u32x4 w; w.x = p0.x; w.y = p0.y; w.z = p1.x; w.w = p1.y;
                    *(u32x4*)xp = w;
                }
                s += __shfl_xor(s, 16); s += __shfl_xor(s, 32);
                if (fq == 0) ssn[(size_t)row * 32 + u.pn * 4 + wc] = s;
            }
    }
};
struct EpiFFN {
    static constexpr bool PAIR = false;
    const LAS float* rst; bf16_t* ACT;
    __device__ __forceinline__ void operator()(const AccT& acc, const pg8::Unit& u, int wr, int wc, int fr, int fq) const {
        const int row0 = u.pm * 256 + wr * 64 + fr;
#pragma unroll
        for (int ai = 0; ai < 2; ++ai)
#pragma unroll
            for (int m = 0; m < 4; ++m) {
                const int row = row0 + ai * 128 + m * 16; const float rs = rst[u.idx * 256 + (row - u.pm * 256)];
                u32x4 w;
#pragma unroll
                for (int bj = 0; bj < 2; ++bj) {
                    const f32x4 g = acc[ai][bj][m][0] * rs, up = acc[ai][bj][m][1] * rs;
                    const u32x2 a = pk4_bf16(g * sigm4(g) * up);
                    if (bj == 0) { w.x = a.x; w.y = a.y; } else { w.z = a.x; w.w = a.y; }
                }
                *(u32x4*)(ACT + tixa((size_t)row, 128 * u.pn + 32 * wc + 8 * fq, FH_)) = w;
            }
    }
};

struct ConvD { const float* s0; const float* s1; const float* gain; bf16_t* dst; int ld0, ld1, inter, K, rt, k0, kperm; };
__device__ __forceinline__ ConvD conv_decode(const Params& p, int item) {
    ConvD d; d.s0 = nullptr; d.s1 = nullptr; d.gain = nullptr; d.ld0 = 0; d.ld1 = 0; d.inter = 0; d.kperm = 0;
    const int l = item / 7552; int it = item % 7552; int kt; size_t doff;
    if (it < 2304) {
        d.rt = it >> 4; kt = it & 15; d.K = 2048; d.kperm = 2; doff = OFF_WIN; d.gain = p.in[1] + l * 2048;
        const float* wl = p.in[4] + (size_t)l * D_ * NIN_;
#pragma unroll
        for (int s = 0; s < 2; ++s) {
            const int sg = 2 * d.rt + s; const float* ptr = nullptr; int ld = NIN_;
            if (sg < 153) ptr = wl + 32 * sg;
            else if (sg == 153) { if (l > 0) { ptr = p.in[17] + (size_t)(l - 1) * D_ * 32; ld = 32; } }
            else if (sg >= 160) ptr = wl + (32 * sg - 224);
            if (s == 0) { d.s0 = ptr; d.ld0 = ld; } else { d.s1 = ptr; d.ld1 = ld; }
        }
    } else if (it < 2560) { it -= 2304; d.rt = it >> 3; kt = it & 7; d.K = 1024; doff = OFF_WBA; d.s0 = p.in[21] + (size_t)l * C_ * D_ + 64 * d.rt; d.s1 = d.s0 + 32; d.ld0 = d.ld1 = D_; }
    else if (it < 2816) { it -= 2560; d.rt = it >> 3; kt = it & 7; d.K = 1024; doff = OFF_WBR; d.s0 = p.in[22] + (size_t)l * C_ * D_ + 64 * d.rt; d.s1 = d.s0 + 32; d.ld0 = d.ld1 = D_; }
    else if (it < 3328) { it -= 2816; d.rt = it >> 4; kt = it & 15; d.K = 2048; d.kperm = 2; doff = OFF_WO; d.s0 = p.in[23] + (size_t)l * D_ * D_ + 64 * d.rt; d.s1 = d.s0 + 32; d.ld0 = d.ld1 = D_; }
    else if (it < 6144) { it -= 3328; d.rt = it >> 4; kt = it & 15; d.K = 2048; d.kperm = 2; doff = OFF_WGU; d.s0 = p.in[24] + (size_t)l * D_ * FH_ + 32 * d.rt; d.s1 = p.in[25] + (size_t)l * D_ * FH_ + 32 * d.rt; d.ld0 = d.ld1 = FH_; d.inter = 1; d.gain = p.in[2] + l * 2048; }
    else { it -= 6144; d.rt = it / 44; kt = it % 44; d.K = 5632; d.kperm = 1; doff = OFF_WD; d.s0 = p.in[26] + (size_t)l * FH_ * D_ + 64 * d.rt; d.s1 = d.s0 + 32; d.ld0 = d.ld1 = D_; }
    d.dst = (bf16_t*)(p.ws + WS_W) + (size_t)l * LSTRIDE + doff; d.k0 = kt * 128;
    return d;
}
__device__ __forceinline__ void conv_load(const ConvD& d, int tid, f32x4 (&v)[4], float (&g)[4]) {
#pragma unroll
    for (int i = 0; i < 4; ++i) {
        const int idx = tid + 512 * i, seg = idx >> 10, rem = idx & 1023, krow = rem >> 3, c4 = rem & 7;
        const float* ptr = seg ? d.s1 : d.s0; const int ld = seg ? d.ld1 : d.ld0;
        v[i] = (f32x4){0.f, 0.f, 0.f, 0.f}; g[i] = 1.0f;
        if (ptr) v[i] = *(const f32x4*)(ptr + (size_t)(d.k0 + krow) * ld + 4 * c4);
        if (d.gain) g[i] = d.gain[d.k0 + krow];
    }
}
__device__ __forceinline__ void conv_store(const ConvD& d, int tid, LAS bf16_t* tile, const f32x4 (&v)[4], const float (&g)[4]) {
#pragma unroll
    for (int i = 0; i < 4; ++i) {
        const int idx = tid + 512 * i, seg = idx >> 10, rem = idx & 1023, krow = rem >> 3, c4 = rem & 7;
        const u32x2 w = pk4_bf16(v[i] * g[i]);
        const int cc = 4 * c4;
        const int r = d.inter ? (32 * (cc >> 4) + 16 * seg + (cc & 15)) : (32 * seg + cc);
        const int kc = d.kperm == 1 ? (32 * ((krow >> 4) & 3) + 8 * ((krow >> 2) & 3) + 4 * (krow >> 6) + (krow & 3))
                     : d.kperm == 2 ? ((krow & ~31) + 8 * ((krow >> 2) & 3) + 4 * ((krow >> 4) & 1) + (krow & 3)) : krow;
        tile[(r + 0) * 136 + kc] = (bf16_t)(w.x & 0xffff); tile[(r + 1) * 136 + kc] = (bf16_t)(w.x >> 16);
        tile[(r + 2) * 136 + kc] = (bf16_t)(w.y & 0xffff); tile[(r + 3) * 136 + kc] = (bf16_t)(w.y >> 16);
    }
    __syncthreads();
#pragma unroll
    for (int i = 0; i < 2; ++i) {
        const int id = tid + 512 * i, blk = id >> 6, within = id & 63, r = 16 * (blk >> 2) + (within >> 2), k = 32 * (blk & 3) + 8 * (within & 3);
        const u32x4 w = *(const LAS u32x4*)(tile + r * 136 + k);
        *(u32x4*)(d.dst + tixa((size_t)(64 * d.rt + r), d.k0 + k, d.K)) = w;
    }
}
constexpr int CV_SLOT = 24, CV_Q = CV_SLOT * 128, CV_REM = 7552 - 2 * CV_Q, CV_P0 = 7552 + 3 * CV_REM;
__device__ __forceinline__ int conv_map(int j, bool p0map) {
    if (!p0map || j < 7552) return j;
    const int jj = j - 7552, L = 1 + jj / CV_REM; return L * 7552 + 2 * CV_Q + jj % CV_REM;
}
__device__ __forceinline__ void conv_run(const Ctx cx, const Params& p, LAS unsigned char* lds, int first, int n, int stride, bool p0map) {
    if (n <= 0) return;
    const int tid = cx.tid;
    f32x4 v[4], nv[4]; float g[4], ng[4];
    ConvD d = conv_decode(p, conv_map(first, p0map));
    conv_load(d, tid, v, g);
    __syncthreads();
#pragma unroll 1
    for (int i = 0; i < n; ++i) {
        ConvD dn = d;
        if (i + 1 < n) { dn = conv_decode(p, conv_map(first + (i + 1) * stride, p0map)); conv_load(dn, tid, nv, ng); }
        conv_store(d, tid, (LAS bf16_t*)lds + (i & 1) * (64 * 136), v, g);
        d = dn;
#pragma unroll
        for (int j = 0; j < 4; ++j) { v[j] = nv[j]; g[j] = ng[j]; }
    }
    __syncthreads();
}
__device__ __forceinline__ void p0_prologue(const Ctx cx, const Params& p, LAS unsigned char* lds) {
    const int tid = cx.tid, G = cx.G, bx = cx.bx, wave = tid >> 6, lane = tid & 63;
    float* SS = (float*)(p.ws + WS_SS);
    {
        const float* x = p.in[0]; bf16_t* XB = (bf16_t*)(p.ws + WS_XB);
        int row = bx * 8 + wave; f32x4 nx[8];
        if (row < M_) {
#pragma unroll
            for (int i = 0; i < 8; ++i) nx[i] = ((const f32x4*)(x + (size_t)row * D_))[lane + 64 * i];
        }
#pragma unroll 1
        for (; row < M_; row += G * 8) {
            f32x4 v[8];
#pragma unroll
            for (int i = 0; i < 8; ++i) v[i] = nx[i];
            if (row + G * 8 < M_) {
#pragma unroll
                for (int i = 0; i < 8; ++i) nx[i] = ((const f32x4*)(x + (size_t)(row + G * 8) * D_))[lane + 64 * i];
            }
            float s = 0.f;
#pragma unroll
            for (int i = 0; i < 8; ++i) { s += dot4(v[i], v[i]);
                const int lc = (lane + 64 * i) * 4, pc = (lc & ~31) + 8 * ((lc >> 2) & 3) + 4 * ((lc >> 4) & 1);
                *(u32x2*)(XB + tixa((size_t)row, pc, D_)) = pk4_bf16(v[i]); }
#pragma unroll
            for (int o = 32; o >= 1; o >>= 1) s += __shfl_xor(s, o);
            if (lane < 32) SS[(size_t)row * 32 + lane] = (lane == 0) ? s : 0.f;
        }
    }
    {
        bf16_t* UPS = (bf16_t*)(p.ws + WS_UPS);
        for (int i = bx * 512 + tid; i < 4 * UPS_L; i += G * 512) {
            const int l = i / UPS_L, r = i % UPS_L, kk_ = r >> 10, ch = r & 1023; float v; int dst;
            if (kk_ < 64) { const int k = kk_; v = p.in[7][((size_t)l * 64 + k) * C_ + ch]; dst = UPS_D + ((ch >> 4) * 2 + (k >> 5)) * 512 + (ch & 15) * 32 + (k & 31); }
            else if (kk_ < 128) { const int k = kk_ - 64; v = p.in[9][((size_t)l * 64 + k) * C_ + ch]; dst = UPS_I + ((ch >> 4) * 2 + (k >> 5)) * 512 + (ch & 15) * 32 + (k & 31); }
            else if (kk_ < 288) { const int k = kk_ - 128; v = p.in[11][((size_t)l * 160 + k) * C_ + ch]; dst = UPS_G + ((ch >> 4) * 5 + (k >> 5)) * 512 + (ch & 15) * 32 + (k & 31); }
            else { const int k = kk_ - 288; v = l > 0 ? p.in[19][((size_t)(l - 1) * 32 + k) * C_ + ch] : 0.f; dst = UPS_V + (ch >> 4) * 512 + (ch & 15) * 32 + k; }
            UPS[(size_t)l * UPS_L + dst] = (bf16_t)(pk_bf16(v, 0.f) & 0xffff);
        }
    }
    if (G == 256) conv_run(cx, p, lds, bx, (CV_P0 - bx + G - 1) / G, G, true);
    else conv_run(cx, p, lds, bx, (4 * 7552 - bx + G - 1) / G, G, false);
}

#define MFMA16(a, b, c) __builtin_amdgcn_mfma_f32_16x16x32_bf16((a), (b), (c), 0, 0, 0)
#define MFMA32(a, b, c) __builtin_amdgcn_mfma_f32_32x32x16_bf16((a), (b), (c), 0, 0, 0)

__device__ __forceinline__ void prep_phase(const Ctx cx, const Params& p, LAS unsigned char* lds, int l) {
    const int tid = cx.tid, wave = tid >> 6, lane = tid & 63, G = cx.G, tl = lane & 15, kq = lane >> 4;
    const bf16_t* PRW = (const bf16_t*)(p.ws + WS_PRW);
    float* SC = (float*)(p.ws + WS_SCAN);
    float* Wo = SC; bf16_t* SB = (bf16_t*)(SC + ARR); bf16_t* KKo = SB, *BBo = SB + ARR, *KMo = SB + 2 * ARR, *Ro = SB + 3 * ARR, *Vo = SB + 4 * ARR;
    float* VF = (float*)(p.ws + WS_VFIRST); bf16_t* Gb = (bf16_t*)(p.ws + WS_G);
    const bf16_t* UPS = (const bf16_t*)(p.ws + WS_UPS) + (size_t)l * UPS_L;
    const float* tsm = p.in[6] + (size_t)l * 3360;
    const float* vmix = p.in[18] + (size_t)(l > 0 ? l - 1 : 0) * 32;
    const float* dbias = p.in[8] + l * C_; const float* ibias = p.in[10] + l * C_; const float* kkp = p.in[12] + l * C_; const float* kap = p.in[13] + l * C_;
    const float* vbias = p.in[20] + (size_t)(l > 0 ? l - 1 : 0) * C_;
    LAS u32x4* fr = (LAS u32x4*)lds + wave * 640 + lane;
#pragma unroll 1
    for (int task = cx.bx * 8 + wave; task < 2048; task += G * 8) {
        const int tile = task >> 2, quarter = task & 3;
        const int row = tile * 16 + tl; const bool hasprev = (row & 2047) != 0;
        const unsigned po = prw_row(row), ppo = hasprev ? prw_row(row - 1) : po; const float pm = hasprev ? 1.0f : 0.0f;
#pragma unroll 5
        for (int s = 0; s < 10; ++s) {
            u32x4 w = {0u, 0u, 0u, 0u};
            if (s < 9 || l > 0) {
                const int col = 3072 + 32 * s + 8 * kq;
                f32x4 c0 = unpk4_bf16(*(const u32x2*)(PRW + (po + prw_col(col)))), c1 = unpk4_bf16(*(const u32x2*)(PRW + (po + prw_col(col + 4))));
                const f32x4 q0 = unpk4_bf16(*(const u32x2*)(PRW + (ppo + prw_col(col)))) * pm, q1 = unpk4_bf16(*(const u32x2*)(PRW + (ppo + prw_col(col + 4)))) * pm;
                const float* mup = (s < 9) ? (tsm + col) : (vmix + 8 * kq);
                const f32x4 m0 = *(const f32x4*)mup, m1 = *(const f32x4*)(mup + 4);
                c0 = c0 + (q0 - c0) * m0; c1 = c1 + (q1 - c1) * m1;
                if (s < 2) {
#pragma unroll
                    for (int e = 0; e < 4; ++e) { c0[e] = tanh_fast(c0[e]); c1[e] = tanh_fast(c1[e]); }
                } else if (s >= 4 && s < 9) { c0 = sigm4(c0); c1 = sigm4(c1); }
                const u32x2 a = pk4_bf16(c0), b = pk4_bf16(c1); w.x = a.x; w.y = a.y; w.z = b.x; w.w = b.y;
            }
            fr[s * 64] = w;
        }
#pragma unroll 1
        for (int hh = 0; hh < 4; ++hh) {
            const int cb = quarter * 256 + hh * 64;
            float ssq = 0.f;
#pragma unroll
            for (int ct = 0; ct < 4; ++ct) {
                const int c = cb + 16 * ct + 4 * kq;
                f32x4 k = unpk4_bf16(*(const u32x2*)(PRW + (po + prw_col(1024 + c)))); const f32x4 kp = unpk4_bf16(*(const u32x2*)(PRW + (ppo + prw_col(1024 + c)))) * pm;
                k = k + (kp - k) * *(const f32x4*)(tsm + 1024 + c);
                const f32x4 kk = k * *(const f32x4*)(kkp + c); ssq += dot4(kk, kk);
            }
            ssq += __shfl_xor(ssq, 16); ssq += __shfl_xor(ssq, 32);
            const float inv = 1.0f / fmaxf(sqrtf(ssq), 1e-12f);
            f32x4 xr, xk, xv, xrp, xkp, xvp, xdb, xib, xkk, xka, xvb, xvf, xmr, xmk, xmv; bf16x8 xu[10];
#define PREP_LOAD(ct_) do { const int c_ = cb + 16 * (ct_) + 4 * kq; \
                xr = unpk4_bf16(*(const u32x2*)(PRW + (po + prw_col(c_)))); xk = unpk4_bf16(*(const u32x2*)(PRW + (po + prw_col(1024 + c_)))); xv = unpk4_bf16(*(const u32x2*)(PRW + (po + prw_col(2048 + c_)))); \
                xrp = unpk4_bf16(*(const u32x2*)(PRW + (ppo + prw_col(c_)))); xkp = unpk4_bf16(*(const u32x2*)(PRW + (ppo + prw_col(1024 + c_)))); xvp = unpk4_bf16(*(const u32x2*)(PRW + (ppo + prw_col(2048 + c_)))); \
                xdb = *(const f32x4*)(dbias + c_); xib = *(const f32x4*)(ibias + c_); xkk = *(const f32x4*)(kkp + c_); xka = *(const f32x4*)(kap + c_); \
                xvb = *(const f32x4*)(vbias + c_); xvf = (l > 0) ? *(const f32x4*)(VF + tix(row, c_)) : (f32x4){0.f, 0.f, 0.f, 0.f}; \
                xmr = *(const f32x4*)(tsm + c_); xmk = *(const f32x4*)(tsm + 1024 + c_); xmv = *(const f32x4*)(tsm + 2048 + c_); } while (0)
#define PREP_LOADU(ct_) do { const int t16_ = (cb >> 4) + (ct_); const bf16_t* ub_ = UPS + tl * 32 + 8 * kq; \
                  _Pragma("unroll") for (int s_ = 0; s_ < 2; ++s_) { xu[s_] = *(const bf16x8*)(ub_ + UPS_D + (t16_ * 2 + s_) * 512); xu[2 + s_] = *(const bf16x8*)(ub_ + UPS_I + (t16_ * 2 + s_) * 512); } \
                  _Pragma("unroll") for (int s_ = 0; s_ < 5; ++s_) xu[4 + s_] = *(const bf16x8*)(ub_ + UPS_G + (t16_ * 5 + s_) * 512); \
                  xu[9] = *(const bf16x8*)(ub_ + UPS_V + t16_ * 512); } while (0)
            PREP_LOAD(0); PREP_LOADU(0);
#pragma unroll 1
            for (int ct = 0; ct < 4; ++ct) {
                const int ch0 = cb + 16 * ct;
                f32x4 aw = {0.f, 0.f, 0.f, 0.f}, aa = aw, ag = aw, avv = aw;
#pragma unroll
                for (int s = 0; s < 2; ++s) aw = MFMA16(xu[s], __builtin_bit_cast(bf16x8, fr[s * 64]), aw);
#pragma unroll
                for (int s = 0; s < 2; ++s) aa = MFMA16(xu[2 + s], __builtin_bit_cast(bf16x8, fr[(2 + s) * 64]), aa);
#pragma unroll
                for (int s = 0; s < 5; ++s) ag = MFMA16(xu[4 + s], __builtin_bit_cast(bf16x8, fr[(4 + s) * 64]), ag);
                if (l > 0) avv = MFMA16(xu[9], __builtin_bit_cast(bf16x8, fr[9 * 64]), avv);
                asm volatile("" ::: "memory"); if (ct < 3) PREP_LOADU(ct + 1);
                const int c = ch0 + 4 * kq; const unsigned o = tix(row, c);
                const f32x4 r = xr + (xrp * pm - xr) * xmr, k = xk + (xkp * pm - xk) * xmk; f32x4 v = xv + (xvp * pm - xv) * xmv;
                *(u32x2*)(Ro + o) = pk4_bf16(r);
                const f32x4 sg = sigm4(xdb + aw);
                f32x4 dec;
#pragma unroll
                for (int e = 0; e < 4; ++e) dec[e] = __expf(-0.6065306597126334f * sg[e]);
                *(f32x4*)(Wo + o) = dec;
                const f32x4 a = sigm4(xib + aa);
                if (l > 0) v = v + (xvf - v) * sigm4(xvb + avv);
                else *(f32x4*)(VF + o) = v;
                *(u32x2*)(Vo + o) = pk4_bf16(v);
                const f32x4 kk = k * xkk * inv;
                *(u32x2*)(KKo + o) = pk4_bf16(kk); *(u32x2*)(BBo + o) = pk4_bf16(kk * a);
                const f32x4 km = k * (1.0f + (a - 1.0f) * xka);
                *(u32x2*)(KMo + o) = pk4_bf16(km);
                *(u32x2*)(Gb + o) = pk4_bf16(ag);
                asm volatile("" ::: "memory"); if (ct < 3) PREP_LOAD(ct + 1);
            }
#undef PREP_LOADU
#undef PREP_LOAD
        }
    }
}

__device__ __forceinline__ bf16x8 pack8(const f32x16& x, const int s) {
    u32x4 w; w.x = pk_bf16(x[8 * s], x[8 * s + 1]); w.y = pk_bf16(x[8 * s + 2], x[8 * s + 3]); w.z = pk_bf16(x[8 * s + 4], x[8 * s + 5]); w.w = pk_bf16(x[8 * s + 6], x[8 * s + 7]);
    return __builtin_bit_cast(bf16x8, w);
}
__device__ __forceinline__ void attn_task(const Params& p, int l, int task, int lane) {
    const bf16_t* QB = (const bf16_t*)(p.ws + WS_QB); const bf16_t* KB = (const bf16_t*)(p.ws + WS_KB); const bf16_t* VT = (const bf16_t*)(p.ws + WS_VT); bf16_t* YA = (bf16_t*)(p.ws + WS_YA);
    const int qt = task & 63, head = (task >> 6) & 15, b = task >> 10;
    const int c = lane & 31, h = lane >> 5, kvh = head >> 2;
    const float slope = exp2f(-0.5f * (float)(head + 1)); const float sink = p.in[5][l * 16 + head];
    const int q0 = qt * 32; const size_t rb = (size_t)b * T_;
    bf16x8 qf[4];
#pragma unroll
    for (int dd = 0; dd < 4; ++dd) qf[dd] = *(const bf16x8*)(QB + (rb + q0 + c) * 1024 + head * 64 + 16 * dd + 8 * h);
    f32x16 S[5];
#pragma unroll
    for (int kt = 0; kt < 5; ++kt) {
        const int key = q0 - 128 + 32 * kt + c, keyc = key < 0 ? 0 : key;
        f32x16 acc;
#pragma unroll
        for (int e = 0; e < 16; ++e) acc[e] = 0.f;
#pragma unroll
        for (int dd = 0; dd < 4; ++dd) acc = MFMA32(*(const bf16x8*)(KB + ((size_t)((b * 4 + kvh) * 4 + dd) * 2048 + keyc) * 16 + 8 * h), qf[dd], acc);
        S[kt] = acc;
    }
    const int t = q0 + c; float mx = sink;
#pragma unroll
    for (int kt = 0; kt < 5; ++kt)
#pragma unroll
        for (int e = 0; e < 16; ++e) {
            const int s = q0 - 128 + 32 * kt + (e & 3) + 8 * (e >> 2) + 4 * h, dist = t - s;
            const bool valid = (dist >= 0) && (dist < 128) && (s >= 0);
            const float val = valid ? (S[kt][e] * 0.125f - slope * (float)dist) : -INFINITY;
            S[kt][e] = val; mx = fmaxf(mx, val);
        }
    mx = fmaxf(mx, __shfl_xor(mx, 32));
    float sum = 0.f;
#pragma unroll
    for (int kt = 0; kt < 5; ++kt)
#pragma unroll
        for (int e = 0; e < 16; ++e) { const float pv = __expf(S[kt][e] - mx); S[kt][e] = pv; sum += pv; }
    sum += __shfl_xor(sum, 32);
    const float inv = 1.0f / (sum + __expf(sink - mx));
    f32x16 O[2];
#pragma unroll
    for (int e = 0; e < 16; ++e) { O[0][e] = 0.f; O[1][e] = 0.f; }
#pragma unroll
    for (int kt = 0; kt < 5; ++kt)
#pragma unroll
        for (int s = 0; s < 2; ++s) {
            const bf16x8 pf = pack8(S[kt], s);
            const int kb = q0 - 128 + 32 * kt + 16 * s + 4 * h; const int k_lo = kb < 0 ? 0 : kb, k_hi = kb + 8 < 0 ? 0 : kb + 8;
#pragma unroll
            for (int dt = 0; dt < 2; ++dt) {
                const bf16_t* vb = VT + (size_t)(b * 4 + kvh) * (512 * 256) + (32 * dt + c) * 4;
                const u32x2 lo = *(const u32x2*)(vb + (k_lo >> 2) * 256), hi = *(const u32x2*)(vb + (k_hi >> 2) * 256);
                u32x4 w; w.x = lo.x; w.y = lo.y; w.z = hi.x; w.w = hi.y;
                O[dt] = MFMA32(__builtin_bit_cast(bf16x8, w), pf, O[dt]);
            }
        }
#pragma unroll
    for (int dt = 0; dt < 2; ++dt)
#pragma unroll
        for (int g4 = 0; g4 < 4; ++g4) {
            const int d = 32 * dt + 8 * g4 + 4 * h;
            f32x4 v = {O[dt][4 * g4] * inv, O[dt][4 * g4 + 1] * inv, O[dt][4 * g4 + 2] * inv, O[dt][4 * g4 + 3] * inv};
            *(u32x2*)(YA + tixa(rb + q0 + c, head * 64 + d, 1024)) = pk4_bf16(v);
        }
}
__device__ __forceinline__ void attn_phase(const Ctx cx, const Params& p, int l) {
    const int wave = cx.tid >> 6, lane = cx.tid & 63;
    for (int task = cx.bx * 8 + wave; task < 4096; task += cx.G * 8) attn_task(p, l, task, lane);
}

struct AttnT { int b, head, kvh, q0, c, h; float slope, sink; size_t rb; };
__device__ __forceinline__ void at_decode(AttnT& t, const Params& p, int l, int task, int lane) {
    const int qt = task & 63; t.head = (task >> 6) & 15; t.b = task >> 10; t.c = lane & 31; t.h = lane >> 5; t.kvh = t.head >> 2;
    t.slope = exp2f(-0.5f * (float)(t.head + 1)); t.sink = p.in[5][l * 16 + t.head]; t.q0 = qt * 32; t.rb = (size_t)t.b * T_;
}
__device__ __forceinline__ void at_load_q(const Params& p, const AttnT& t, bf16x8 (&qf)[4]) {
    const bf16_t* QB = (const bf16_t*)(p.ws + WS_QB);
#pragma unroll
    for (int dd = 0; dd < 4; ++dd) qf[dd] = *(const bf16x8*)(QB + (t.rb + t.q0 + t.c) * 1024 + t.head * 64 + 16 * dd + 8 * t.h);
}
template <int BASE> __device__ __forceinline__ void at_load_k(const Params& p, const AttnT& t, int kt, u32x4 (&buf)[4]) {
    const bf16_t* KB = (const bf16_t*)(p.ws + WS_KB);
    const int key = t.q0 - 128 + 32 * kt + t.c, keyc = key < 0 ? 0 : key;
#pragma unroll
    for (int dd = 0; dd < 4; ++dd) buf[BASE + dd] = *(const u32x4*)(KB + ((size_t)((t.b * 4 + t.kvh) * 4 + dd) * 2048 + keyc) * 16 + 8 * t.h);
}
template <int BASE> __device__ __forceinline__ void at_qk(const bf16x8 (&qf)[4], const u32x4 (&buf)[4], f32x16& S) {
    f32x16 acc;
#pragma unroll
    for (int e = 0; e < 16; ++e) acc[e] = 0.f;
#pragma unroll
    for (int dd = 0; dd < 4; ++dd) acc = MFMA32(__builtin_bit_cast(bf16x8, buf[BASE + dd]), qf[dd], acc);
    S = acc;
}
__device__ __forceinline__ float at_softmax_a(const AttnT& t, f32x16 (&S)[5]) {
    const int tq = t.q0 + t.c; float mx = t.sink;
#pragma unroll
    for (int kt = 0; kt < 5; ++kt)
#pragma unroll
        for (int e = 0; e < 16; ++e) {
            const int s = t.q0 - 128 + 32 * kt + (e & 3) + 8 * (e >> 2) + 4 * t.h, dist = tq - s;
            const bool valid = (dist >= 0) && (dist < 128) && (s >= 0);
            const float val = valid ? (S[kt][e] * 0.125f - t.slope * (float)dist) : -INFINITY;
            S[kt][e] = val; mx = fmaxf(mx, val);
        }
    return fmaxf(mx, __shfl_xor(mx, 32));
}
__device__ __forceinline__ float at_softmax_b(const AttnT& t, f32x16 (&S)[5], float mx) {
    float sum = 0.f;
#pragma unroll
    for (int kt = 0; kt < 5; ++kt)
#pragma unroll
        for (int e = 0; e < 16; ++e) { const float pv = __expf(S[kt][e] - mx); S[kt][e] = pv; sum += pv; }
    sum += __shfl_xor(sum, 32);
    return 1.0f / (sum + __expf(t.sink - mx));
}
template <int BASE> __device__ __forceinline__ void at_load_v(const Params& p, const AttnT& t, int kt, u32x4 (&buf)[4]) {
    const bf16_t* VT = (const bf16_t*)(p.ws + WS_VT);
#pragma unroll
    for (int s = 0; s < 2; ++s) {
        const int kb = t.q0 - 128 + 32 * kt + 16 * s + 4 * t.h; const int k_lo = kb < 0 ? 0 : kb, k_hi = kb + 8 < 0 ? 0 : kb + 8;
#pragma unroll
        for (int dt = 0; dt < 2; ++dt) {
            const bf16_t* vb = VT + (size_t)(t.b * 4 + t.kvh) * (512 * 256) + (32 * dt + t.c) * 4;
            const u32x2 lo = *(const u32x2*)(vb + (k_lo >> 2) * 256), hi = *(const u32x2*)(vb + (k_hi >> 2) * 256);
            u32x4 w; w.x = lo.x; w.y = lo.y; w.z = hi.x; w.w = hi.y; buf[BASE + 2 * s + dt] = w;
        }
    }
}
template <int BASE> __device__ __forceinline__ void at_pv(const f32x16& Skt, const u32x4 (&buf)[4], f32x16 (&O)[2]) {
#pragma unroll
    for (int s = 0; s < 2; ++s) {
        const bf16x8 pf = pack8(Skt, s);
#pragma unroll
        for (int dt = 0; dt < 2; ++dt) O[dt] = MFMA32(__builtin_bit_cast(bf16x8, buf[BASE + 2 * s + dt]), pf, O[dt]);
    }
}
__device__ __forceinline__ void at_store(const Params& p, const AttnT& t, const f32x16 (&O)[2], float inv) {
    bf16_t* YA = (bf16_t*)(p.ws + WS_YA);
#pragma unroll
    for (int dt = 0; dt < 2; ++dt)
#pragma unroll
        for (int g4 = 0; g4 < 4; ++g4) {
            const int d = 32 * dt + 8 * g4 + 4 * t.h;
            f32x4 v = {O[dt][4 * g4] * inv, O[dt][4 * g4 + 1] * inv, O[dt][4 * g4 + 2] * inv, O[dt][4 * g4 + 3] * inv};
            *(u32x2*)(YA + tixa(t.rb + t.q0 + t.c, t.head * 64 + d, 1024)) = pk4_bf16(v);
        }
}

constexpr int SC_CH = 32, SC_STEP = 336;
__device__ __forceinline__ void scan_phase(const Ctx cx, const Params& p, LAS unsigned char* lds, int l, bool fuse_attn) {
    const int tid = cx.tid, wave = __builtin_amdgcn_readfirstlane(tid >> 6), lane = tid & 63, G = cx.G;
    const float* SC = (const float*)(p.ws + WS_SCAN); float* YRAW = (float*)(p.ws + WS_PRW);
    LAS float* ring = (LAS float*)lds;
    for (int tb = cx.bx; tb < 256; tb += G) {
        const int bh = tb >> 2, q = tb & 3, b = bh >> 4, hd = bh & 15;
        const size_t rowb = (size_t)b * T_; const int cbase = hd * 64;
        __syncthreads();
        if (tid >= 256) {
            int ht = tid - 256; asm volatile("" : "+v"(ht));
            const bf16_t* SBh = (const bf16_t*)(SC + ARR);
            const unsigned gw0 = tix((int)rowb + (ht >> 4), cbase + 4 * (ht & 15)), lw0 = (unsigned)((ht >> 4) * SC_STEP + 64 + 4 * (ht & 15));
            const unsigned gb0 = tix((int)rowb + (ht >> 3), cbase + 8 * (ht & 7)), lb0 = (unsigned)((ht >> 3) * SC_STEP + 8 * (ht & 7));
            unsigned gv, lv;
#define gw(i) (gw0 + (unsigned)(i) * 16384u)
#define lw(i) (lw0 + (unsigned)(i) * (16u * SC_STEP))
#define gb(i) (gb0 + (unsigned)(i) * (unsigned)ARR)
#define lb(i) (lb0 + ((i) == 0 ? 0u : 64u + 64u * (unsigned)(i)))
            { const int j = ht & 63, step = j >> 1, c8 = j & 1; gv = 4u * (unsigned)ARR + tix((int)rowb + step, cbase + 16 * q + 8 * c8); lv = (unsigned)(step * SC_STEP + 320 + 8 * c8); }
            const bool hasv = ht < 64;
            f32x4 tw[2]; u32x4 tb[4], tv = {0u, 0u, 0u, 0u};
#define SCAN_LOAD(cofs_) do { _Pragma("unroll") for (int i = 0; i < 2; ++i) tw[i] = *(const f32x4*)(SC + (size_t)(gw(i) + (cofs_))); \
                _Pragma("unroll") for (int i = 0; i < 4; ++i) tb[i] = *(const u32x4*)(SBh + (size_t)(gb(i) + (cofs_))); \
                if (hasv) tv = *(const u32x4*)(SBh + (size_t)(gv + (cofs_))); } while (0)
#define SCAN_PUT8(dst_, w_) do { f32x4 lo_, hi_; lo_[0] = __uint_as_float((w_).x << 16); lo_[1] = __uint_as_float((w_).x & 0xffff0000u); lo_[2] = __uint_as_float((w_).y << 16); lo_[3] = __uint_as_float((w_).y & 0xffff0000u); \
                hi_[0] = __uint_as_float((w_).z << 16); hi_[1] = __uint_as_float((w_).z & 0xffff0000u); hi_[2] = __uint_as_float((w_).w << 16); hi_[3] = __uint_as_float((w_).w & 0xffff0000u); \
                *(LAS f32x4*)(dst_) = lo_; *(LAS f32x4*)((dst_) + 4) = hi_; } while (0)
#define SCAN_STORE(buf_) do { _Pragma("unroll") for (int i = 0; i < 2; ++i) *(LAS f32x4*)((buf_) + lw(i)) = tw[i]; \
                _Pragma("unroll") for (int i = 0; i < 4; ++i) SCAN_PUT8((buf_) + lb(i), tb[i]); \
                if (hasv) SCAN_PUT8((buf_) + lv, tv); } while (0)
            SCAN_LOAD(0u);
            SCAN_STORE(ring);
            SCAN_LOAD((unsigned)SC_CH * C_);
            __syncthreads();
#define SCAN_HB(c_) do { const int cc_ = (c_); if (cc_ < T_ / SC_CH) { LAS float* hb_ = ring + (cc_ & 1) * SC_CH * SC_STEP; SCAN_STORE(hb_); \
                if (cc_ + 1 < T_ / SC_CH) { const unsigned cofs_ = (unsigned)(cc_ + 1) * SC_CH * C_; SCAN_LOAD(cofs_); } } __syncthreads(); } while (0)
            const int hwid = cx.bx * 4 + (wave - 4);
            const bool act = fuse_attn;
#pragma unroll 1
            for (int grp = 0; grp < 4; ++grp) {
                const int cb = 1 + grp * 16;
                AttnT at; bf16x8 qf[4]; u32x4 ab[4]; f32x16 S[5]; f32x16 O[2]; float inv = 0.f, mx = 0.f;
                int task_ = grp * 1024 + hwid; asm volatile("" : "+s"(task_));
                int ln_ = lane; asm volatile("" : "+v"(ln_));
                if (act) { at_decode(at, p, l, task_, ln_); at_load_q(p, at, qf); at_load_k<0>(p, at, 0, ab); }
                SCAN_HB(cb + 0);
                if (act) { at_qk<0>(qf, ab, S[0]); at_load_k<0>(p, at, 1, ab); }
                SCAN_HB(cb + 1);
                if (act) { at_qk<0>(qf, ab, S[1]); at_load_k<0>(p, at, 2, ab); }
                SCAN_HB(cb + 2);
                if (act) { at_qk<0>(qf, ab, S[2]); at_load_k<0>(p, at, 3, ab); }
                SCAN_HB(cb + 3);
                if (act) { at_qk<0>(qf, ab, S[3]); at_load_k<0>(p, at, 4, ab); }
                SCAN_HB(cb + 4);
                if (act) { at_qk<0>(qf, ab, S[4]); }
                SCAN_HB(cb + 5);
                if (act) { mx = at_softmax_a(at, S); }
                SCAN_HB(cb + 6);
                if (act) { inv = at_softmax_b(at, S, mx); at_load_v<0>(p, at, 0, ab); }
                SCAN_HB(cb + 7);
                if (act) {
#pragma unroll
                    for (int e = 0; e < 16; ++e) { O[0][e] = 0.f; O[1][e] = 0.f; }
                    at_pv<0>(S[0], ab, O); at_load_v<0>(p, at, 1, ab); }
                SCAN_HB(cb + 8);
                if (act) { at_pv<0>(S[1], ab, O); at_load_v<0>(p, at, 2, ab); }
                SCAN_HB(cb + 9);
                if (act) { at_pv<0>(S[2], ab, O); at_load_v<0>(p, at, 3, ab); }
                SCAN_HB(cb + 10);
                if (act) { at_pv<0>(S[3], ab, O); at_load_v<0>(p, at, 4, ab); }
                SCAN_HB(cb + 11);
                if (act) { at_pv<0>(S[4], ab, O); at_store(p, at, O, inv); }
                SCAN_HB(cb + 12);
                SCAN_HB(cb + 13);
                SCAN_HB(cb + 14);
                SCAN_HB(cb + 15);
            }
#undef SCAN_HB
#undef gw
#undef lw
#undef gb
#undef lb
#undef SCAN_LOAD
#undef SCAN_PUT8
#undef SCAN_STORE
        } else {
            int lane_s = lane; asm volatile("" : "+v"(lane_s));
            const int jg = lane_s & 15, ri = lane_s >> 4;
            f32x2 Sa = {0.f, 0.f}, Sb = {0.f, 0.f};
            __builtin_amdgcn_s_setprio(3);
            __syncthreads();
            for (int c = 0; c < T_ / SC_CH; ++c) {
                const LAS float* base = ring + (c & 1) * SC_CH * SC_STEP;
                float* yp = YRAW + tix((int)rowb + c * SC_CH + jg, cbase + 16 * q + 4 * wave + ri);
                const LAS float* lp = base + 4 * jg; const LAS float* vp = base + 320 + 4 * wave + ri;
                f32x4 kk = *(const LAS f32x4*)(lp), w = *(const LAS f32x4*)(lp + 64), bb = *(const LAS f32x4*)(lp + 128), km = *(const LAS f32x4*)(lp + 192), r = *(const LAS f32x4*)(lp + 256);
                float v = vp[0];
#pragma unroll 1
                for (int g16 = 0; g16 < SC_CH / 16; ++g16) {
                    float ykeep = 0.f;
#pragma unroll
                    for (int s16 = 0; s16 < 16; ++s16) {
                        f32x4 nkk = kk, nw = w, nbb = bb, nkm = km, nr = r; float nv = v;
                        if (s16 < 15 || g16 + 1 < SC_CH / 16) {
                            const LAS float* np = lp + (g16 * 16 + s16 + 1) * SC_STEP;
                            nkk = *(const LAS f32x4*)(np); nw = *(const LAS f32x4*)(np + 64); nbb = *(const LAS f32x4*)(np + 128); nkm = *(const LAS f32x4*)(np + 192); nr = *(const LAS f32x4*)(np + 256);
                            nv = vp[(g16 * 16 + s16 + 1) * SC_STEP];
                        }
                        const f32x2 dd = Sa * kk.xy + Sb * kk.zw;
                        const float d = red16(dd.x + dd.y);
                        const f32x2 ta = km.xy * v - bb.xy * d, tb2 = km.zw * v - bb.zw * d;
                        Sa = Sa * w.xy + ta; Sb = Sb * w.zw + tb2;
                        const f32x2 yy = Sa * r.xy + Sb * r.zw;
                        const float y = red16(yy.x + yy.y);
                        ykeep = (jg == s16) ? y : ykeep;
                        kk = nkk; w = nw; bb = nbb; km = nkm; r = nr; v = nv;
                    }
                    yp[g16 * 16384] = ykeep;
                }
                __syncthreads();
            }
            __builtin_amdgcn_s_setprio(0);
        }
    }
}

__device__ __forceinline__ void post_phase(const Ctx cx, const Params& p, int l) {
    const int wave = cx.tid >> 6, lane = cx.tid & 63, jg = lane & 15;
    const float* YRAW = (const float*)(p.ws + WS_PRW); const float* SC = (const float*)(p.ws + WS_SCAN);
    const bf16_t* SB = (const bf16_t*)(SC + ARR); const bf16_t* KMi = SB + 2 * ARR, *Ri = SB + 3 * ARR, *Vi = SB + 4 * ARR; const bf16_t* Gb = (const bf16_t*)(p.ws + WS_G); bf16_t* YR = (bf16_t*)(p.ws + WS_YR);
    const float* rk = p.in[14] + l * C_; const float* lw = p.in[15] + l * C_; const float* lb = p.in[16] + l * C_;
    const int NIT = M_ * 16 / 4, stride = cx.G * 8;
    int it = cx.bx * 8 + wave;
    f32x4 ny = {0.f, 0.f, 0.f, 0.f}; u32x2 nr = {0u, 0u}, nkm = nr, nv = nr, ng = nr;
#define POST_LOAD(it_) do { const int row_ = ((it_) >> 4) * 4 + (lane >> 4), c_ = ((it_) & 15) * 64 + 4 * jg; const unsigned o_ = tix(row_, c_); \
        ny = *(const f32x4*)(YRAW + o_); nr = *(const u32x2*)(Ri + o_); nkm = *(const u32x2*)(KMi + o_); nv = *(const u32x2*)(Vi + o_); ng = *(const u32x2*)(Gb + o_); } while (0)
    if (it < NIT) POST_LOAD(it);
#pragma unroll 1
    for (; it < NIT; it += stride) {
        const int row = (it >> 4) * 4 + (lane >> 4), hd = it & 15, c = hd * 64 + 4 * jg;
        const f32x4 y = ny; const u32x2 pr_ = nr, pkm = nkm, pv_ = nv, pg = ng;
        if (it + stride < NIT) POST_LOAD(it + stride);
        const f32x4 rkc = *(const f32x4*)(rk + c), lwc = *(const f32x4*)(lw + c), lbc = *(const f32x4*)(lb + c);
        const float mean = red16((y[0] + y[1]) + (y[2] + y[3])) * (1.0f / 64.0f);
        const f32x4 d = y - mean; const float var = red16(dot4(d, d)) * (1.0f / 64.0f); const float rstd = rsqrtf(var + LNX_EPS);
        const f32x4 r = unpk4_bf16(pr_), km = unpk4_bf16(pkm), v = unpk4_bf16(pv_), g = unpk4_bf16(pg);
        const float bonus = red16(dot4(r * km, rkc));
        const f32x4 outv = ((d * rstd) * lwc + lbc + bonus * v) * g;
        *(u32x2*)(YR + tixa((size_t)row, c, 1024)) = pk4_bf16(outv);
    }
#undef POST_LOAD
}

__device__ __forceinline__ void final_phase(const Ctx cx, const Params& p) {
    const bf16_t* XB = (const bf16_t*)(p.ws + WS_XB); const float* ss = (const float*)(p.ws + WS_SS) + (size_t)8 * M_ * 32; const float* g = p.in[3];
    const int wave = cx.tid >> 6, lane = cx.tid & 63, stride = cx.G * 8;
    int row = cx.bx * 8 + wave; u32x2 nx[8]; float nsq = 0.f;
    f32x4 gv[8]; int pc[8];
#pragma unroll
    for (int i = 0; i < 8; ++i) { const int lc = (lane + 64 * i) * 4; gv[i] = *(const f32x4*)(g + lc); pc[i] = (lc & ~31) + 8 * ((lc >> 2) & 3) + 4 * ((lc >> 4) & 1); }
    if (row < M_) { nsq = ss[(size_t)row * 32 + (lane & 31)];
#pragma unroll
        for (int i = 0; i < 8; ++i) nx[i] = *(const u32x2*)(XB + tixa((size_t)row, pc[i], D_)); }
#pragma unroll 1
    for (; row < M_; row += stride) {
        u32x2 v[8]; float sq = nsq;
#pragma unroll
        for (int i = 0; i < 8; ++i) v[i] = nx[i];
        if (row + stride < M_) { nsq = ss[(size_t)(row + stride) * 32 + (lane & 31)];
#pragma unroll
            for (int i = 0; i < 8; ++i) nx[i] = *(const u32x2*)(XB + tixa((size_t)(row + stride), pc[i], D_)); }
#pragma unroll
        for (int o = 16; o >= 1; o >>= 1) sq += __shfl_xor(sq, o);
        const float rs = rsqrtf(sq * (1.0f / 2048.0f) + NORM_EPS);
        f32x4* orow = (f32x4*)(p.out + (size_t)row * D_);
#pragma unroll
        for (int i = 0; i < 8; ++i) orow[lane + 64 * i] = unpk4_bf16(v[i]) * rs * gv[i];
    }
}

#define XB_TMO      128
#define XB_XCNT(j)  (256  + 64 * (j))
#define XB_XSUB(j)  (1280 + 64 * (j))
#define XB_XGEN(j)  (2304 + 64 * (j))
#define XB_TOP      3328
#define XB_TOPGEN   3392
#define XCD_BAR_WORDS 3456
#define XB_SPIN_CAP (1u << 20)
__device__ __forceinline__ unsigned xb_ld(unsigned* p)              { return __hip_atomic_load(p, __ATOMIC_RELAXED, __HIP_MEMORY_SCOPE_AGENT); }
__device__ __forceinline__ unsigned xb_add(unsigned* p, unsigned v) { return __hip_atomic_fetch_add(p, v, __ATOMIC_RELAXED, __HIP_MEMORY_SCOPE_AGENT); }
__device__ __forceinline__ unsigned xb_xcc_id() { return (unsigned)__builtin_amdgcn_s_getreg((3 << 11) | 20) & 0xFu; }
#define XB_SPIN(cond, bar) do { unsigned _sp = 0; while (cond) { __builtin_amdgcn_s_sleep(1); \
    if ((++_sp & 255u) == 0u) { if (xb_ld(&(bar)[XB_TMO])) break; if (_sp > XB_SPIN_CAP) { atomicAdd(&(bar)[XB_TMO], 1u); break; } } } } while (0)
struct XcdBarrier { unsigned* bar; unsigned x; volatile LAS unsigned* st; };
__device__ __forceinline__ XcdBarrier xcd_barrier_post(unsigned* bar, volatile LAS unsigned* st, bool leader) {
    XcdBarrier b; b.bar = bar; b.x = xb_xcc_id(); b.st = st;
    if (leader) (void)xb_add(&bar[XB_XCNT(b.x)], 1u);
    return b;
}
__device__ __forceinline__ void xcd_barrier_complete(unsigned* bar, unsigned x, unsigned& nloc, unsigned& nx) {
    const unsigned G = gridDim.x * gridDim.y * gridDim.z;
    unsigned sum, cnt, mine, sp = 0u;
    for (;;) {
        sum = 0u; cnt = 0u; mine = 0u;
#pragma unroll
        for (unsigned j = 0; j < 16; ++j) { const unsigned c = xb_ld(&bar[XB_XCNT(j)]); sum += c; cnt += (c > 0u) ? 1u : 0u; mine = (j == x) ? c : mine; }
        if (sum == G) break;
        __builtin_amdgcn_s_sleep(1);
        if ((++sp & 255u) == 0u) { if (xb_ld(&bar[XB_TMO])) break; if (sp > XB_SPIN_CAP) { atomicAdd(&bar[XB_TMO], 1u); break; } }
    }
    nloc = mine > 0u ? mine : 1u; nx = cnt > 0u ? cnt : 1u;
}
__device__ __forceinline__ void xcd_barrier(const XcdBarrier& b, bool leader) {
    asm volatile("s_waitcnt vmcnt(0)" ::: "memory");
    __syncthreads();
    if (leader) {
        unsigned* bar = b.bar;
        __builtin_amdgcn_s_waitcnt(0);
        unsigned nloc = b.st[0], nx = b.st[1];
        if (nloc == 0u) { xcd_barrier_complete(bar, b.x, nloc, nx); b.st[0] = nloc; b.st[1] = nx; }
        const unsigned old = xb_add(&bar[XB_XSUB(b.x)], 1u);
        const unsigned gen = old / nloc;
        if (old + 1u == (gen + 1u) * nloc) {
            __builtin_amdgcn_fence(__ATOMIC_RELEASE, "agent");
            asm volatile("s_waitcnt vmcnt(0)" ::: "memory");
            const unsigned og = xb_add(&bar[XB_TOP], 1u);
            const unsigned tg = og / nx;
            if (og + 1u == (tg + 1u) * nx) xb_add(&bar[XB_TOPGEN], 1u);
            else XB_SPIN(xb_ld(&bar[XB_TOPGEN]) == tg, bar);
            __builtin_amdgcn_fence(__ATOMIC_ACQUIRE, "agent");
            xb_add(&bar[XB_XGEN(b.x)], 1u);
            asm volatile("s_waitcnt vmcnt(0)" ::: "memory");
        } else {
            XB_SPIN(xb_ld(&bar[XB_XGEN(b.x)]) == gen, bar);
            __builtin_amdgcn_fence(__ATOMIC_ACQUIRE, "agent");
            asm volatile("s_waitcnt vmcnt(0)" ::: "memory");
        }
    }
    __syncthreads();
}

constexpr int N_PHASES = 34;
__global__ void __launch_bounds__(512, 2) fwd_kernel(Params p_arg) {
    extern __shared__ __attribute__((aligned(16))) unsigned char smem[];
    LAS unsigned char* lds = (LAS unsigned char*)smem;
    cg::grid_group grid = cg::this_grid();
    const int ph_lo = p_arg.ph_lo, ph_hi = p_arg.ph_hi;
    volatile LAS unsigned* bst = (volatile LAS unsigned*)(lds + LDS_STAGE);
    const int wave_id_ = __builtin_amdgcn_readfirstlane((int)threadIdx.x >> 6);
    if (threadIdx.x == 0) { bst[0] = 0u; bst[1] = 0u; }
    __syncthreads();
    XcdBarrier xbar; xbar.bar = (unsigned*)(p_arg.ws + WS_BAR); xbar.x = 0; xbar.st = bst;
    if (ph_hi - ph_lo > 1) xbar = xcd_barrier_post((unsigned*)(p_arg.ws + WS_BAR), bst, threadIdx.x == 0);
    for (int ph = ph_lo; ph < ph_hi; ++ph) {
        if (ph > ph_lo) { if (ph_lo < 0) grid.sync(); else { int l0_; asm volatile("v_mbcnt_lo_u32_b32 %0, -1, 0\n\tv_mbcnt_hi_u32_b32 %0, -1, %0" : "=v"(l0_)); xcd_barrier(xbar, wave_id_ == 0 && l0_ == 0); } }
        Ctx cx; { int ln_; asm volatile("v_mbcnt_lo_u32_b32 %0, -1, 0\n\tv_mbcnt_hi_u32_b32 %0, -1, %0" : "=v"(ln_));
        int t_ = wave_id_ * 64 + ln_, b_ = blockIdx.x, g_ = gridDim.x; asm volatile("" : "+v"(t_)); asm volatile("" : "+s"(b_)); asm volatile("" : "+s"(g_)); cx.tid = t_; cx.bx = b_; cx.G = g_; }
        const Params& p = p_arg;
        const int G = cx.G, bx = cx.bx;
        unsigned char* ws = p.ws;
        const bf16_t* XB = (const bf16_t*)(ws + WS_XB); float* SS = (float*)(ws + WS_SS); float* XRES = (float*)(ws + WS_XRES);
        if (ph == 0) { for (int r_ = 0; r_ < REP_P0; ++r_) p0_prologue(cx, p, lds); continue; }
        if (ph == N_PHASES - 1) { final_phase(cx, p); continue; }
        const int l = (ph - 1) >> 3, k = (ph - 1) & 7;
        const bf16_t* WL = (const bf16_t*)(ws + WS_W) + (size_t)l * LSTRIDE;
        pg8::StaticOrder S;
        if (k == 0) {
            pg8::Gemm g{XB, WL + OFF_WIN, M_, NP_, D_}; S.init(M_, NP_, G, bx);
            rs_table_fill(cx, lds, S, SS + (size_t)(2 * l) * M_ * 32);
            EpiInProj E{(const LAS float*)(lds + LDS_RST), (bf16_t*)(ws + WS_QB), (bf16_t*)(ws + WS_KB), (bf16_t*)(ws + WS_VT), (bf16_t*)(ws + WS_PRW), (bf16_t*)(ws + WS_SG)};
            for (int r_ = 0; r_ < REP_INPROJ; ++r_) pg8::gemm_phase(cx, lds, g, S, E);
            if (G == 256 && bx >= 128 && l < 3) conv_run(cx, p, lds, (l + 1) * 7552 + (bx - 128), CV_SLOT, 128, false);
        } else if (k == 1) { for (int r_ = 0; r_ < REP_PREP; ++r_) prep_phase(cx, p, lds, l); if (G != 256) attn_phase(cx, p, l); }
        else if (k == 2) { for (int r_ = 0; r_ < REP_SCAN; ++r_) scan_phase(cx, p, lds, l, G == 256); }
        else if (k == 3) { for (int r_ = 0; r_ < REP_POST; ++r_) post_phase(cx, p, l); }
        else if (k == 4) {
            pg8::PairOrder SP; SP.init(M_, D_, G, bx);
            pg8::Gemm g{(const bf16_t*)(ws + WS_YA), WL + OFF_WBA, 2 * M_, 2 * D_, C_};
            EpiBranchPair E{(const bf16_t*)(ws + WS_SG), (bf16_t*)(ws + WS_MRG)};
            pg8::gemm_phase(cx, lds, g, SP, E);
        } else if (k == 5) {
            pg8::Gemm g{(const bf16_t*)(ws + WS_MRG), WL + OFF_WO, M_, D_, D_}; S.init(M_, D_, G, bx);
            EpiResid E{(bf16_t*)(ws + WS_XB), SS + (size_t)(2 * l + 1) * M_ * 32};
            pg8::gemm_phase(cx, lds, g, S, E);
        } else if (k == 6) {
            pg8::Gemm g{XB, WL + OFF_WGU, M_, 2 * FH_, D_}; S.init(M_, 2 * FH_, G, bx);
            rs_table_fill(cx, lds, S, SS + (size_t)(2 * l + 1) * M_ * 32);
            EpiFFN E{(const LAS float*)(lds + LDS_RST), (bf16_t*)(ws + WS_PRW)};
            for (int r_ = 0; r_ < REP_GU; ++r_) pg8::gemm_phase(cx, lds, g, S, E);
            if (G == 256 && bx >= 128 && l < 3) conv_run(cx, p, lds, (l + 1) * 7552 + CV_Q + (bx - 128), CV_SLOT, 128, false);
        } else {
            pg8::Gemm g{(const bf16_t*)(ws + WS_PRW), WL + OFF_WD, M_, D_, FH_}; S.init(M_, D_, G, bx);
            EpiResid E{(bf16_t*)(ws + WS_XB), SS + (size_t)(2 * l + 2) * M_ * 32};
            pg8::gemm_phase(cx, lds, g, S, E);
        }
    }
}

extern "C" void kernel_launch(void* const* d_in, const int* in_sizes, int n_in, void* d_out, int out_size, void* d_ws, size_t ws_size, hipStream_t stream) {
    static int grid_blocks = 0;
    if (!grid_blocks) {
        if (n_in != 27 || ws_size < WS_END) { fprintf(stderr, "kernel_launch: unexpected n_in %d / ws_size %zu (need %zu)\n", n_in, ws_size, (size_t)WS_END); grid_blocks = -1; return; }
        int dev = 0, cus = 0, per_cu = 0;
        hipGetDevice(&dev);
        hipDeviceGetAttribute(&cus, hipDeviceAttributeMultiprocessorCount, dev);
        if (hipFuncSetAttribute((const void*)fwd_kernel, hipFuncAttributeMaxDynamicSharedMemorySize, LDS_BYTES) != hipSuccess) { fprintf(stderr, "kernel_launch: hipFuncSetAttribute failed\n"); grid_blocks = -1; return; }
        hipOccupancyMaxActiveBlocksPerMultiprocessor(&per_cu, (const void*)fwd_kernel, 512, LDS_BYTES);
        if (per_cu < 1) { fprintf(stderr, "kernel_launch: occupancy query says %d blocks per CU\n", per_cu); per_cu = 1; }
        (void)hipGetLastError();
        grid_blocks = cus;
        if (grid_blocks < 236) { fprintf(stderr, "kernel_launch: %d CUs: the per-phase rstd table holds 6 units per workgroup (needs >= 236 workgroups)\n", cus); grid_blocks = -1; return; }
    }
    if (grid_blocks < 0) return;
    Params p{};
    for (int i = 0; i < 27; ++i) p.in[i] = (const float*)d_in[i];
    p.out = (float*)d_out; p.ws = (unsigned char*)d_ws;
#if FUSED
    p.ph_lo = 0; p.ph_hi = N_PHASES;
    if (hipMemsetAsync((unsigned char*)d_ws + WS_BAR, 0, 16384, stream) != hipSuccess) { fprintf(stderr, "kernel_launch: memset of the barrier words failed\n"); return; }
    void* args[] = {&p};
    hipError_t e = hipLaunchCooperativeKernel((const void*)fwd_kernel, dim3(grid_blocks), dim3(512), args, LDS_BYTES, stream);
    if (e != hipSuccess) fprintf(stderr, "cooperative launch failed: %s (grid %d)\n", hipGetErrorString(e), grid_blocks);
#else
    for (int ph = 0; ph < N_PHASES; ++ph) {
        p.ph_lo = ph; p.ph_hi = ph + 1;
        hipLaunchKernelGGL(fwd_kernel, dim3(grid_blocks), dim3(512), LDS_BYTES, stream, p);
    }
#endif
}
```

```cpp
#include <hip/hip_runtime.h>
#include <hip/hip_cooperative_groups.h>
#include <cstdio>
namespace cg = cooperative_groups;

#ifndef FUSED
#define FUSED 1
#endif

#ifndef REP_P0
#define REP_P0 1
#endif
#ifndef REP_INPROJ
#define REP_INPROJ 1
#endif
#ifndef REP_PREP
#define REP_PREP 1
#endif
#ifndef REP_ATTN
#define REP_ATTN 1
#endif
#ifndef REP_SCAN
#define REP_SCAN 1
#endif
#ifndef REP_POST
#define REP_POST 1
#endif
#ifndef REP_BR
#define REP_BR 1
#endif
#ifndef REP_GU
#define REP_GU 1
#endif

#define LAS __attribute__((address_space(3)))
typedef unsigned short bf16_t;
typedef short bf16x8 __attribute__((ext_vector_type(8)));
typedef float f32x2 __attribute__((ext_vector_type(2)));
typedef float f32x4 __attribute__((ext_vector_type(4)));
typedef float f32x16 __attribute__((ext_vector_type(16)));
typedef unsigned u32x2 __attribute__((ext_vector_type(2)));
typedef unsigned u32x4 __attribute__((ext_vector_type(4)));
typedef __bf16 nbf2 __attribute__((ext_vector_type(2)));

constexpr int M_ = 8192, D_ = 2048, T_ = 2048, C_ = 1024, FH_ = 5632, NP_ = 9216, NIN_ = 8992, PRWW_ = 3584;
constexpr float NORM_EPS = 1e-5f, LNX_EPS = 64e-5f;

constexpr size_t OFF_WIN = 0, OFF_WBA = OFF_WIN + (size_t)NP_ * D_, OFF_WBR = OFF_WBA + (size_t)D_ * C_, OFF_WO = OFF_WBR + (size_t)D_ * C_,
                 OFF_WGU = OFF_WO + (size_t)D_ * D_, OFF_WD = OFF_WGU + (size_t)2 * FH_ * D_, LSTRIDE = OFF_WD + (size_t)D_ * FH_;
constexpr int UPS_L = 1024 * 320;
constexpr int UPS_D = 0, UPS_I = 65536, UPS_G = 131072, UPS_V = 294912;
constexpr size_t ARR = (size_t)M_ * C_;

constexpr size_t WS_W = 0;
constexpr size_t WS_UPS = WS_W + 4 * LSTRIDE * 2;
constexpr size_t WS_XRES = WS_UPS + (size_t)4 * UPS_L * 2;
constexpr size_t WS_XB = WS_XRES + (size_t)M_ * D_ * 4;
constexpr size_t WS_SS = WS_XB + (size_t)M_ * D_ * 2;
constexpr size_t WS_QB = WS_SS + (size_t)9 * M_ * 32 * 4;
constexpr size_t WS_KB = WS_QB + ARR * 2;
constexpr size_t WS_VT = WS_KB + (size_t)M_ * 256 * 2;
constexpr size_t WS_SG = WS_VT + (size_t)M_ * 256 * 2;
constexpr size_t WS_VFIRST = WS_SG + (size_t)M_ * 4096 * 2;
constexpr size_t WS_G = WS_VFIRST + ARR * 4;
constexpr size_t WS_YA = WS_G + ARR * 2;
constexpr size_t WS_YR = WS_YA + ARR * 2;
constexpr size_t WS_MRG = WS_YR + ARR * 2;
constexpr size_t WS_PRW = WS_MRG + (size_t)M_ * D_ * 2;
constexpr size_t WS_SCAN = WS_PRW + (size_t)M_ * PRWW_ * 4;
constexpr size_t WS_BAR = WS_SCAN + 6 * ARR * 4;
constexpr size_t WS_END = WS_BAR + 16384;
static_assert((size_t)M_ * FH_ * 2 <= (size_t)M_ * PRWW_ * 4, "ACT alias");

constexpr int LDS_STAGE = 131072, LDS_RST = LDS_STAGE + 16, LDS_BYTES = LDS_RST + 6 * 1024;

struct Params { const float* in[27]; float* out; unsigned char* ws; int ph_lo, ph_hi; };
struct Ctx { int tid, bx, G; };

__device__ __forceinline__ unsigned pk_bf16(float lo, float hi) { f32x2 v = {lo, hi}; nbf2 b = __builtin_convertvector(v, nbf2); return __builtin_bit_cast(unsigned, b); }
__device__ __forceinline__ u32x2 pk4_bf16(f32x4 v) { u32x2 r; r.x = pk_bf16(v[0], v[1]); r.y = pk_bf16(v[2], v[3]); return r; }
__device__ __forceinline__ f32x4 unpk4_bf16(u32x2 w) { f32x4 r; r[0] = __uint_as_float(w.x << 16); r[1] = __uint_as_float(w.x & 0xffff0000u); r[2] = __uint_as_float(w.y << 16); r[3] = __uint_as_float(w.y & 0xffff0000u); return r; }
__device__ __forceinline__ float sigm(float x) { return __builtin_amdgcn_rcpf(1.0f + __expf(-x)); }
__device__ __forceinline__ float tanh_fast(float x) { return 1.0f - 2.0f * __builtin_amdgcn_rcpf(1.0f + __expf(2.0f * x)); }
__device__ __forceinline__ f32x4 sigm4(f32x4 v) { f32x4 r; r[0] = sigm(v[0]); r[1] = sigm(v[1]); r[2] = sigm(v[2]); r[3] = sigm(v[3]); return r; }
__device__ __forceinline__ float dot4(f32x4 a, f32x4 b) { return (a[0] * b[0] + a[1] * b[1]) + (a[2] * b[2] + a[3] * b[3]); }
__device__ __forceinline__ float dppf(float x, const int ctrl) { return x; }
#define DPP_ADD(x, ctrl) ((x) + __int_as_float(__builtin_amdgcn_update_dpp(0, __float_as_int(x), (ctrl), 0xF, 0xF, false)))
__device__ __forceinline__ float red16(float x) { x = DPP_ADD(x, 0xB1); x = DPP_ADD(x, 0x4E); x = DPP_ADD(x, 0x141); x = DPP_ADD(x, 0x140); return x; }

__device__ __forceinline__ unsigned prw_row(int row) { return (unsigned)(row >> 4) * (unsigned)(PRWW_ * 16) + (unsigned)(row & 15) * 16u; }
__device__ __forceinline__ unsigned prw_col(int col) { return (unsigned)(col >> 4) * 256u + (unsigned)(col & 15); }
__device__ __forceinline__ unsigned tix(int row, int col) { return (unsigned)(row >> 4) * 16384u + (unsigned)(col >> 4) * 256u + (unsigned)(row & 15) * 16u + (unsigned)(col & 15); }
__device__ __forceinline__ size_t tixa(size_t r, int k, int K) { return ((r >> 4) * (size_t)(K >> 5) + (size_t)(k >> 5)) * 512 + (size_t)((int)(r & 15) * 32 + (k & 31)); }
__device__ __forceinline__ float row_ss(const float* ss, int row, int fq) {
    const f32x4 a = *(const f32x4*)(ss + (size_t)row * 32 + fq * 8), b = *(const f32x4*)(ss + (size_t)row * 32 + fq * 8 + 4);
    float s = ((a[0] + a[1]) + (a[2] + a[3])) + ((b[0] + b[1]) + (b[2] + b[3]));
    s += __shfl_xor(s, 16); s += __shfl_xor(s, 32); return s;
}

namespace pg8 {
constexpr int BM = 256, BK = 64, HALF = 128, HTB = HALF * BK * 2, STAGE_BYTES = 8 * HTB, NXCD = 8, WGM = 8;
__device__ __forceinline__ int lds_byte(int r, int c) { const int st = (r >> 4) * 2 + (c >> 5), rr = r & 15, cc = c & 31, ob = rr * 64 + cc * 2; return st * 1024 + (ob ^ (((ob >> 9) & 1) << 5)); }
__device__ __forceinline__ void stage_rc(int b, int& R, int& Cc) { const int st = b / 1024, sb = b % 1024, swz = sb ^ (((sb >> 9) & 1) << 5); R = (st >> 1) * 16 + swz / 64; Cc = (st & 1) * 32 + (swz % 64) / 2; }
struct Unit { int pm, pn, idx; };
struct Gemm { const bf16_t* A; const bf16_t* Bt; int M, N, K; };
struct StaticOrder {
    int nM, nN, nwg, G, c;
    __device__ void init(int M, int N, int G_, int c_) { nM = M / BM; nN = N / BM; nwg = nM * nN; G = G_; c = c_; }
    __device__ bool next(int i, Unit& u) const {
        const long L = (long)i * G + c; if (L >= nwg) return false;
        int wgid = (int)L; { const int q = nwg / NXCD, r = nwg % NXCD, xcd = wgid % NXCD, off = wgid / NXCD; wgid = (xcd < r ? xcd * (q + 1) : r * (q + 1) + (xcd - r) * q) + off; }
        const int nig = WGM * nN, gid = wgid / nig, fm = gid * WGM, gsz = (nM - fm) < WGM ? (nM - fm) : WGM;
        u.pm = fm + ((wgid % nig) % gsz); u.pn = (wgid % nig) / gsz; u.idx = i; return true;
    }
};

struct PairOrder : StaticOrder {
    __device__ bool next(int i, Unit& u) const { if (!StaticOrder::next(i >> 1, u)) return false; if (i & 1) { u.pm += 32; u.pn += 8; } return true; }
};

template <class Epi, class Sched>
__device__ __forceinline__ void gemm_phase(const Ctx cx, LAS unsigned char* lds, const Gemm g, const Sched& S, const Epi& E) {
    const int tid = cx.tid, wid = __builtin_amdgcn_readfirstlane(tid >> 6), lane = tid & 63, wr = wid >> 2, wc = wid & 3, fr = lane & 15, fq = lane >> 4;
    const int K = g.K, nt = K / BK;
    unsigned voffA[2];
#pragma unroll
    for (int i = 0; i < 2; ++i) { int R, Cc; stage_rc(tid * 16 + i * 8192, R, Cc); voffA[i] = (unsigned)(((R >> 4) * (K >> 5) + (Cc >> 5)) * 512 + (R & 15) * 32 + (Cc & 31)) * 2u; }
    const size_t kstep = (size_t)(2 * 512 * 2);
    const size_t hstep = (size_t)HALF * K * 2;
    const size_t tstep = 2 * hstep;
    const unsigned ldsw = (unsigned)wid * 1024u;
    const int aoff = lds_byte(wr * 64 + fr, fq * 8), boff = lds_byte(wc * 32 + fr, fq * 8);
#define PG8_SA(b, h) (((b) * 2 + (h)) * HTB)
#define PG8_SB(b, h) ((4 + (b) * 2 + (h)) * HTB)
#define PG8_STAGE(bufoff, gbase) do { _Pragma("unroll") for (int _i = 0; _i < 2; ++_i) \
        __builtin_amdgcn_global_load_lds((const unsigned*)((const char*)(gbase) + voffA[_i]), (LAS unsigned*)(lds + (bufoff) + ldsw + _i * 8192), 16, 0, 0); } while (0)
#define PG8_LDA(dst, b, h) do { _Pragma("unroll") for (int m = 0; m < 4; ++m) _Pragma("unroll") for (int k = 0; k < 2; ++k) dst[m][k] = *(const LAS bf16x8*)(lds + PG8_SA(b, h) + aoff + m * 2048 + k * 1024); } while (0)
#define PG8_LDB(dst, b, h) do { _Pragma("unroll") for (int n = 0; n < 2; ++n) _Pragma("unroll") for (int k = 0; k < 2; ++k) dst[n][k] = *(const LAS bf16x8*)(lds + PG8_SB(b, h) + boff + n * 2048 + k * 1024); } while (0)
#define PG8_MMA(ai, bj, At, Bt) do { __builtin_amdgcn_s_setprio(1); _Pragma("unroll") for (int m = 0; m < 4; ++m) _Pragma("unroll") for (int n = 0; n < 2; ++n) _Pragma("unroll") for (int k = 0; k < 2; ++k) \
        acc[ai][bj][m][n] = __builtin_amdgcn_mfma_f32_16x16x32_bf16(Bt[n][k], At[m][k], acc[ai][bj][m][n], 0, 0, 0); __builtin_amdgcn_s_setprio(0); } while (0)
#define PG8_WAIT_V(n) asm volatile("s_waitcnt vmcnt(" #n ")" ::: "memory")
#define PG8_WAIT_L(n) asm volatile("s_waitcnt lgkmcnt(" #n ")" ::: "memory")
#define PG8_BAR __builtin_amdgcn_s_barrier()
#define PG8_SCHED __builtin_amdgcn_sched_barrier(0)
    Unit cur, nxt; int ui = 0;
    if (!S.next(0, cur)) return;
    f32x4 acc[2][2][4][2];
#pragma unroll
    for (int a = 0; a < 2; ++a)
#pragma unroll
        for (int b = 0; b < 2; ++b)
#pragma unroll
            for (int m = 0; m < 4; ++m)
#pragma unroll
                for (int n = 0; n < 2; ++n) acc[a][b][m][n] = (f32x4){0.f, 0.f, 0.f, 0.f};
    bf16x8 At[4][2], B0[2][2], B1[2][2];
    const char* cA = (const char*)g.A + (size_t)cur.pm * tstep; const char* cB = (const char*)g.Bt + (size_t)cur.pn * tstep;
    PG8_STAGE(PG8_SB(0, 0), cB); PG8_STAGE(PG8_SA(0, 0), cA); PG8_STAGE(PG8_SB(0, 1), cB + hstep); PG8_STAGE(PG8_SA(0, 1), cA + hstep);
    if (wr == 1) PG8_BAR;
    PG8_WAIT_V(4); PG8_BAR;
    PG8_STAGE(PG8_SB(1, 0), cB + kstep); PG8_STAGE(PG8_SA(1, 0), cA + kstep); PG8_STAGE(PG8_SB(1, 1), cB + hstep + kstep);
    PG8_WAIT_V(6); PG8_BAR;
    for (;;) {
        const bool has_next = S.next(ui + 1, nxt);
        const char* nA = has_next ? (const char*)g.A + (size_t)nxt.pm * tstep : cA; const char* nB = has_next ? (const char*)g.Bt + (size_t)nxt.pn * tstep : cB;
        for (int t = 0; t < nt; t += 2) {
            const bool last = (t == nt - 2);
            const char* a1 = cA + (size_t)(t + 1) * kstep;
            const char* a2 = last ? nA : cA + (size_t)(t + 2) * kstep; const char* b2 = last ? nB : cB + (size_t)(t + 2) * kstep;
            const char* a3 = a2 + kstep; const char* b3 = b2 + kstep;
            PG8_LDB(B0, 0, 0); PG8_SCHED; PG8_LDA(At, 0, 0); PG8_STAGE(PG8_SA(1, 1), a1 + hstep);
            PG8_WAIT_L(8); PG8_BAR; PG8_WAIT_L(0); PG8_MMA(0, 0, At, B0); PG8_BAR; PG8_SCHED;
            PG8_LDB(B1, 0, 1); PG8_STAGE(PG8_SB(0, 0), b2);
            PG8_BAR; PG8_WAIT_L(0); PG8_MMA(0, 1, At, B1); PG8_BAR;
            PG8_LDA(At, 0, 1); PG8_STAGE(PG8_SA(0, 0), a2);
            PG8_BAR; PG8_WAIT_L(0); PG8_MMA(1, 0, At, B0); PG8_BAR; PG8_SCHED;
            PG8_STAGE(PG8_SB(0, 1), b2 + hstep);
            PG8_WAIT_V(6); PG8_BAR; PG8_MMA(1, 1, At, B1); PG8_BAR;
            PG8_LDB(B0, 1, 0); PG8_SCHED; PG8_LDA(At, 1, 0); PG8_STAGE(PG8_SA(0, 1), a2 + hstep);
            PG8_WAIT_L(8); PG8_BAR; PG8_WAIT_L(0); PG8_MMA(0, 0, At, B0); PG8_BAR; PG8_SCHED;
            PG8_LDB(B1, 1, 1); PG8_STAGE(PG8_SB(1, 0), b3);
            PG8_BAR; PG8_WAIT_L(0); PG8_MMA(0, 1, At, B1); PG8_BAR;
            PG8_LDA(At, 1, 1); PG8_STAGE(PG8_SA(1, 0), a3);
            PG8_BAR; PG8_WAIT_L(0); PG8_MMA(1, 0, At, B0); PG8_BAR; PG8_SCHED;
            PG8_STAGE(PG8_SB(1, 1), b3 + hstep);
            PG8_WAIT_V(6); PG8_BAR; PG8_MMA(1, 1, At, B1); PG8_BAR;
        }
        bool keep = false;
        if constexpr (Epi::PAIR) { if (cur.pm < 32) { E.mid(acc, cur, wr, wc, fr, fq); keep = true; } else E(acc, cur, wr, wc, fr, fq); }
        else E(acc, cur, wr, wc, fr, fq);
        if (!has_next) break;
        if (!keep)
#pragma unroll
        for (int a = 0; a < 2; ++a)
#pragma unroll
            for (int b = 0; b < 2; ++b)
#pragma unroll
                for (int m = 0; m < 4; ++m)
#pragma unroll
                    for (int n = 0; n < 2; ++n) acc[a][b][m][n] = (f32x4){0.f, 0.f, 0.f, 0.f};
        cur = nxt; cA = nA; cB = nB; ++ui;
    }
    PG8_WAIT_V(0);
    if (wr == 0) PG8_BAR;
    PG8_BAR;
#undef PG8_SA
#undef PG8_SB
#undef PG8_STAGE
#undef PG8_LDA
#undef PG8_LDB
#undef PG8_MMA
#undef PG8_WAIT_V
#undef PG8_WAIT_L
#undef PG8_BAR
#undef PG8_SCHED
}
}

typedef f32x4 AccT[2][2][4][2];

__device__ __forceinline__ void rs_table_fill(const Ctx cx, LAS unsigned char* lds, const pg8::StaticOrder& S, const float* ss) {
    LAS float* tab = (LAS float*)(lds + LDS_RST);
    const int t = cx.tid & 255, par = cx.tid >> 8;
    float sq[3]; bool ok[3];
#pragma unroll
    for (int k = 0; k < 3; ++k) {
        pg8::Unit u; ok[k] = S.next(2 * k + par, u); sq[k] = 0.f;
        if (ok[k]) { const float* sp = ss + (size_t)(u.pm * 256 + t) * 32;
#pragma unroll
            for (int j = 0; j < 8; ++j) { const f32x4 a = *(const f32x4*)(sp + 4 * j); sq[k] += (a[0] + a[1]) + (a[2] + a[3]); } }
    }
#pragma unroll
    for (int k = 0; k < 3; ++k) if (ok[k]) tab[(2 * k + par) * 256 + t] = rsqrtf(sq[k] * (1.0f / 2048.0f) + NORM_EPS);
    __syncthreads();
}
struct EpiInProj {
    static constexpr bool PAIR = false;
    const LAS float* rst; bf16_t* QB; bf16_t* KB; bf16_t* VT; bf16_t* PRW; bf16_t* SG;
    __device__ __forceinline__ void operator()(const AccT& acc, const pg8::Unit& u, int wr, int wc, int fr, int fq) const {
        const int row0 = u.pm * 256 + wr * 64 + fr, col0 = u.pn * 256 + wc * 32 + 4 * fq; const int pn = u.pn;
#pragma unroll
        for (int ai = 0; ai < 2; ++ai)
#pragma unroll
            for (int m = 0; m < 4; ++m) {
                const int row = row0 + ai * 128 + m * 16; const float rs = rst[u.idx * 256 + (row - u.pm * 256)];
#pragma unroll
                for (int bj = 0; bj < 2; ++bj) {
                    if (pn >= 20) {
                        const u32x2 a = pk4_bf16(sigm4(acc[ai][bj][m][0] * rs)), b = pk4_bf16(sigm4(acc[ai][bj][m][1] * rs));
                        u32x4 w; w.x = a.x; w.y = a.y; w.z = b.x; w.w = b.y;
                        *(u32x4*)(SG + tixa((size_t)row, (pn * 256 + bj * 128 + wc * 32 - 5120) + 8 * fq, 4096)) = w;
                    } else
#pragma unroll
                    for (int n = 0; n < 2; ++n) {
                        const int c = col0 + bj * 128 + n * 16; const f32x4 v = acc[ai][bj][m][n] * rs;
                        if (pn < 4) *(u32x2*)(QB + (size_t)row * 1024 + c) = pk4_bf16(v);
                        else if (pn == 4) { const int cc = c - 1024, kvh = cc >> 6, d = cc & 63, b = row >> 11, t = row & 2047;
                            *(u32x2*)(KB + ((size_t)((b * 4 + kvh) * 4 + (d >> 4)) * 2048 + t) * 16 + (d & 15)) = pk4_bf16(v); }
                        else if (pn == 5) { const int cc = c - 1280, kvh = cc >> 6, d = cc & 63, b = row >> 11, t = row & 2047; bf16_t* vp = VT + ((size_t)(b * 4 + kvh) * 512 + (t >> 2)) * 256 + d * 4 + (t & 3);
                            const u32x2 w = pk4_bf16(v); vp[0] = (bf16_t)(w.x & 0xffff); vp[4] = (bf16_t)(w.x >> 16); vp[8] = (bf16_t)(w.y & 0xffff); vp[12] = (bf16_t)(w.y >> 16); }
                        else *(u32x2*)(PRW + (prw_row(row) + prw_col(c - 1536))) = pk4_bf16(v);
                    }
                }
            }
    }
};
template <int SECOND> struct EpiBranch {
    static constexpr bool PAIR = false;
    const bf16_t* SG; float* MRGF; bf16_t* MRG;
    __device__ __forceinline__ void operator()(const AccT& acc, const pg8::Unit& u, int wr, int wc, int fr, int fq) const {
        const int row0 = u.pm * 256 + wr * 64 + fr, col0 = u.pn * 256 + wc * 32 + 4 * fq;
#pragma unroll
        for (int ai = 0; ai < 2; ++ai)
#pragma unroll
            for (int m = 0; m < 4; ++m) {
                const int row = row0 + ai * 128 + m * 16;
#pragma unroll
                for (int bj = 0; bj < 2; ++bj)
#pragma unroll
                    for (int n = 0; n < 2; ++n) {
                        const int c = col0 + bj * 128 + n * 16;
                        const f32x4 sg = unpk4_bf16(*(const u32x2*)(SG + (size_t)row * 4096 + SECOND * 2048 + c));
                        float* mp = MRGF + (size_t)row * 2048 + c;
                        if (!SECOND) *(f32x4*)mp = sg * acc[ai][bj][m][n];
                        else { const f32x4 o = *(const f32x4*)mp + sg * acc[ai][bj][m][n]; *(u32x2*)(MRG + (size_t)row * 2048 + c) = pk4_bf16(o); }
                    }
            }
    }
};
struct EpiBranchPair {
    static constexpr bool PAIR = true;
    const bf16_t* SG; bf16_t* MRG;
    __device__ __forceinline__ void mid(AccT& acc, const pg8::Unit& u, int wr, int wc, int fr, int fq) const {
        const int row0 = u.pm * 256 + wr * 64 + fr, col0 = u.pn * 256 + wc * 32 + 4 * fq;
#pragma unroll
        for (int ai = 0; ai < 2; ++ai)
#pragma unroll
            for (int m = 0; m < 4; ++m) {
                const int row = row0 + ai * 128 + m * 16;
#pragma unroll
                for (int bj = 0; bj < 2; ++bj) {
                    const int gc = (u.pn * 256 + bj * 128 + wc * 32) + 8 * fq;
                    const u32x4 sa8 = *(const u32x4*)(SG + tixa((size_t)row, gc, 4096)), sb8 = *(const u32x4*)(SG + tixa((size_t)row, 2048 + gc, 4096));
#pragma unroll
                    for (int n = 0; n < 2; ++n) {
                        const f32x4 sa = unpk4_bf16(n ? (u32x2){sa8.z, sa8.w} : (u32x2){sa8.x, sa8.y}), sb = unpk4_bf16(n ? (u32x2){sb8.z, sb8.w} : (u32x2){sb8.x, sb8.y});
                        f32x4 q; q[0] = sa[0] * __builtin_amdgcn_rcpf(sb[0]); q[1] = sa[1] * __builtin_amdgcn_rcpf(sb[1]); q[2] = sa[2] * __builtin_amdgcn_rcpf(sb[2]); q[3] = sa[3] * __builtin_amdgcn_rcpf(sb[3]);
                        acc[ai][bj][m][n] = acc[ai][bj][m][n] * q;
                    }
                }
            }
    }
    __device__ __forceinline__ void operator()(const AccT& acc, const pg8::Unit& u, int wr, int wc, int fr, int fq) const {
        const int row0 = (u.pm - 32) * 256 + wr * 64 + fr, col0 = (u.pn - 8) * 256 + wc * 32 + 4 * fq;
#pragma unroll
        for (int ai = 0; ai < 2; ++ai)
#pragma unroll
            for (int m = 0; m < 4; ++m) {
                const int row = row0 + ai * 128 + m * 16;
#pragma unroll
                for (int bj = 0; bj < 2; ++bj) {
                    const u32x4 sb8 = *(const u32x4*)(SG + tixa((size_t)row, 2048 + ((u.pn - 8) * 256 + bj * 128 + wc * 32) + 8 * fq, 4096));
                    const u32x2 m0 = pk4_bf16(acc[ai][bj][m][0] * unpk4_bf16((u32x2){sb8.x, sb8.y})), m1 = pk4_bf16(acc[ai][bj][m][1] * unpk4_bf16((u32x2){sb8.z, sb8.w}));
                    u32x4 w; w.x = m0.x; w.y = m0.y; w.z = m1.x; w.w = m1.y;
                    *(u32x4*)(MRG + tixa((size_t)row, ((u.pn - 8) * 256 + bj * 128 + wc * 32) + 8 * fq, 2048)) = w;
                }
            }
    }
};
struct EpiResid {
    static constexpr bool PAIR = false;
    bf16_t* XB; float* ssn;
    __device__ __forceinline__ void operator()(const AccT& acc, const pg8::Unit& u, int wr, int wc, int fr, int fq) const {
        const int row0 = u.pm * 256 + wr * 64 + fr;
#pragma unroll
        for (int ai = 0; ai < 2; ++ai)
#pragma unroll
            for (int m = 0; m < 4; ++m) {
                const int row = row0 + ai * 128 + m * 16; float s = 0.f;
#pragma unroll
                for (int bj = 0; bj < 2; ++bj) {
                    bf16_t* xp = XB + tixa((size_t)row, (u.pn * 256 + bj * 128 + wc * 32) + 8 * fq, 2048);
                    const u32x4 b8 = *(const u32x4*)xp;
                    const f32x4 x0 = unpk4_bf16((u32x2){b8.x, b8.y}) + acc[ai][bj][m][0], x1 = unpk4_bf16((u32x2){b8.z, b8.w}) + acc[ai][bj][m][1];
                    s += dot4(x0, x0) + dot4(x1, x1);
                    const u32x2 p0 = pk4_bf16(x0), p1 = pk4_bf16(x1);
                    u32x4 w; w.x = p0.x; w.y = p0.y; w.z = p1.x; w.w = p1.y;
                    *(u32x4*)xp = w;
                }
                s += __shfl_xor(s, 16); s += __shfl_xor(s, 32);
                if (fq == 0) ssn[(size_t)row * 32 + u.pn * 4 + wc] = s;
            }
    }
};
struct EpiFFN {
    static constexpr bool PAIR = false;
    const LAS float* rst; bf16_t* ACT;
    __device__ __forceinline__ void operator()(const AccT& acc, const pg8::Unit& u, int wr, int wc, int fr, int fq) const {
        const int row0 = u.pm * 256 + wr * 64 + fr;
#pragma unroll
        for (int ai = 0; ai < 2; ++ai)
#pragma unroll
            for (int m = 0; m < 4; ++m) {
                const int row = row0 + ai * 128 + m * 16; const float rs = rst[u.idx * 256 + (row - u.pm * 256)];
                u32x4 w;
#pragma unroll
                for (int bj = 0; bj < 2; ++bj) {
                    const f32x4 g = acc[ai][bj][m][0] * rs, up = acc[ai][bj][m][1] * rs;
                    const u32x2 a = pk4_bf16(g * sigm4(g) * up);
                    if (bj == 0) { w.x = a.x; w.y = a.y; } else { w.z = a.x; w.w = a.y; }
                }
                *(u32x4*)(ACT + tixa((size_t)row, 128 * u.pn + 32 * wc + 8 * fq, FH_)) = w;
            }
    }
};

struct ConvD { const float* s0; const float* s1; const float* gain; bf16_t* dst; int ld0, ld1, inter, K, rt, k0, kperm; };
__device__ __forceinline__ ConvD conv_decode(const Params& p, int item) {
    ConvD d; d.s0 = nullptr; d.s1 = nullptr; d.gain = nullptr; d.ld0 = 0; d.ld1 = 0; d.inter = 0; d.kperm = 0;
    const int l = item / 7552; int it = item % 7552; int kt; size_t doff;
    if (it < 2304) {
        d.rt = it >> 4; kt = it & 15; d.K = 2048; d.kperm = 2; doff = OFF_WIN; d.gain = p.in[1] + l * 2048;
        const float* wl = p.in[4] + (size_t)l * D_ * NIN_;
#pragma unroll
        for (int s = 0; s < 2; ++s) {
            const int sg = 2 * d.rt + s; const float* ptr = nullptr; int ld = NIN_;
            if (sg < 153) ptr = wl + 32 * sg;
            else if (sg == 153) { if (l > 0) { ptr = p.in[17] + (size_t)(l - 1) * D_ * 32; ld = 32; } }
            else if (sg >= 160) ptr = wl + (32 * sg - 224);
            if (s == 0) { d.s0 = ptr; d.ld0 = ld; } else { d.s1 = ptr; d.ld1 = ld; }
        }
    } else if (it < 2560) { it -= 2304; d.rt = it >> 3; kt = it & 7; d.K = 1024; doff = OFF_WBA; d.s0 = p.in[21] + (size_t)l * C_ * D_ + 64 * d.rt; d.s1 = d.s0 + 32; d.ld0 = d.ld1 = D_; }
    else if (it < 2816) { it -= 2560; d.rt = it >> 3; kt = it & 7; d.K = 1024; doff = OFF_WBR; d.s0 = p.in[22] + (size_t)l * C_ * D_ + 64 * d.rt; d.s1 = d.s0 + 32; d.ld0 = d.ld1 = D_; }
    else if (it < 3328) { it -= 2816; d.rt = it >> 4; kt = it & 15; d.K = 2048; d.kperm = 2; doff = OFF_WO; d.s0 = p.in[23] + (size_t)l * D_ * D_ + 64 * d.rt; d.s1 = d.s0 + 32; d.ld0 = d.ld1 = D_; }
    else if (it < 6144) { it -= 3328; d.rt = it >> 4; kt = it & 15; d.K = 2048; d.kperm = 2; doff = OFF_WGU; d.s0 = p.in[24] + (size_t)l * D_ * FH_ + 32 * d.rt; d.s1 = p.in[25] + (size_t)l * D_ * FH_ + 32 * d.rt; d.ld0 = d.ld1 = FH_; d.inter = 1; d.gain = p.in[2] + l * 2048; }
    else { it -= 6144; d.rt = it / 44; kt = it % 44; d.K = 5632; d.kperm = 1; doff = OFF_WD; d.s0 = p.in[26] + (size_t)l * FH_ * D_ + 64 * d.rt; d.s1 = d.s0 + 32; d.ld0 = d.ld1 = D_; }
    d.dst = (bf16_t*)(p.ws + WS_W) + (size_t)l * LSTRIDE + doff; d.k0 = kt * 128;
    return d;
}
__device__ __forceinline__ void conv_load(const ConvD& d, int tid, f32x4 (&v)[4], float (&g)[4]) {
#pragma unroll
    for (int i = 0; i < 4; ++i) {
        const int idx = tid + 512 * i, seg = idx >> 10, rem = idx & 1023, krow = rem >> 3, c4 = rem & 7;
        const float* ptr = seg ? d.s1 : d.s0; const int ld = seg ? d.ld1 : d.ld0;
        v[i] = (f32x4){0.f, 0.f, 0.f, 0.f}; g[i] = 1.0f;
        if (ptr) v[i] = *(const f32x4*)(ptr + (size_t)(d.k0 + krow) * ld + 4 * c4);
        if (d.gain) g[i] = d.gain[d.k0 + krow];
    }
}
__device__ __forceinline__ void conv_store(const ConvD& d, int tid, LAS bf16_t* tile, const f32x4 (&v)[4], const float (&g)[4]) {
#pragma unroll
    for (int i = 0; i < 4; ++i) {
        const int idx = tid + 512 * i, seg = idx >> 10, rem = idx & 1023, krow = rem >> 3, c4 = rem & 7;
        const u32x2 w = pk4_bf16(v[i] * g[i]);
        const int cc = 4 * c4;
        const int r = d.inter ? (32 * (cc >> 4) + 16 * seg + (cc & 15)) : (32 * seg + cc);
        const int kc = d.kperm == 1 ? (32 * ((krow >> 4) & 3) + 8 * ((krow >> 2) & 3) + 4 * (krow >> 6) + (krow & 3))
                     : d.kperm == 2 ? ((krow & ~31) + 8 * ((krow >> 2) & 3) + 4 * ((krow >> 4) & 1) + (krow & 3)) : krow;
        tile[(r + 0) * 136 + kc] = (bf16_t)(w.x & 0xffff); tile[(r + 1) * 136 + kc] = (bf16_t)(w.x >> 16);
        tile[(r + 2) * 136 + kc] = (bf16_t)(w.y & 0xffff); tile[(r + 3) * 136 + kc] = (bf16_t)(w.y >> 16);
    }
    __syncthreads();
#pragma unroll
    for (int i = 0; i < 2; ++i) {
        const int id = tid + 512 * i, blk = id >> 6, within = id & 63, r = 16 * (blk >> 2) + (within >> 2), k = 32 * (blk & 3) + 8 * (within & 3);
        const u32x4 w = *(const LAS u32x4*)(tile + r * 136 + k);
        *(u32x4*)(d.dst + tixa((size_t)(64 * d.rt + r), d.k0 + k, d.K)) = w;
    }
}
constexpr int CV_SLOT = 24, CV_Q = CV_SLOT * 128, CV_REM = 7552 - 2 * CV_Q, CV_P0 = 7552 + 3 * CV_REM;
__device__ __forceinline__ int conv_map(int j, bool p0map) {
    if (!p0map || j < 7552) return j;
    const int jj = j - 7552, L = 1 + jj / CV_REM; return L * 7552 + 2 * CV_Q + jj % CV_REM;
}
__device__ __forceinline__ void conv_run(const Ctx cx, const Params& p, LAS unsigned char* lds, int first, int n, int stride, bool p0map) {
    if (n <= 0) return;
    const int tid = cx.tid;
    f32x4 v[4], nv[4]; float g[4], ng[4];
    ConvD d = conv_decode(p, conv_map(first, p0map));
    conv_load(d, tid, v, g);
    __syncthreads();
#pragma unroll 1
    for (int i = 0; i < n; ++i) {
        ConvD dn = d;
        if (i + 1 < n) { dn = conv_decode(p, conv_map(first + (i + 1) * stride, p0map)); conv_load(dn, tid, nv, ng); }
        conv_store(d, tid, (LAS bf16_t*)lds + (i & 1) * (64 * 136), v, g);
        d = dn;
#pragma unroll
        for (int j = 0; j < 4; ++j) { v[j] = nv[j]; g[j] = ng[j]; }
    }
    __syncthreads();
}
__device__ __forceinline__ void p0_prologue(const Ctx cx, const Params& p, LAS unsigned char* lds) {
    const int tid = cx.tid, G = cx.G, bx = cx.bx, wave = tid >> 6, lane = tid & 63;
    float* SS = (float*)(p.ws + WS_SS);
    {
        const float* x = p.in[0]; bf16_t* XB = (bf16_t*)(p.ws + WS_XB);
        int row = bx * 8 + wave; f32x4 nx[8];
        if (row < M_) {
#pragma unroll
            for (int i = 0; i < 8; ++i) nx[i] = ((const f32x4*)(x + (size_t)row * D_))[lane + 64 * i];
        }
#pragma unroll 1
        for (; row < M_; row += G * 8) {
            f32x4 v[8];
#pragma unroll
            for (int i = 0; i < 8; ++i) v[i] = nx[i];
            if (row + G * 8 < M_) {
#pragma unroll
                for (int i = 0; i < 8; ++i) nx[i] = ((const f32x4*)(x + (size_t)(row + G * 8) * D_))[lane + 64 * i];
            }
            float s = 0.f;
#pragma unroll
            for (int i = 0; i < 8; ++i) { s += dot4(v[i], v[i]);
                const int lc = (lane + 64 * i) * 4, pc = (lc & ~31) + 8 * ((lc >> 2) & 3) + 4 * ((lc >> 4) & 1);
                *(u32x2*)(XB + tixa((size_t)row, pc, D_)) = pk4_bf16(v[i]); }
#pragma unroll
            for (int o = 32; o >= 1; o >>= 1) s += __shfl_xor(s, o);
            if (lane < 32) SS[(size_t)row * 32 + lane] = (lane == 0) ? s : 0.f;
        }
    }
    {
        bf16_t* UPS = (bf16_t*)(p.ws + WS_UPS);
        for (int i = bx * 512 + tid; i < 4 * UPS_L; i += G * 512) {
            const int l = i / UPS_L, r = i % UPS_L, kk_ = r >> 10, ch = r & 1023; float v; int dst;
            if (kk_ < 64) { const int k = kk_; v = p.in[7][((size_t)l * 64 + k) * C_ + ch]; dst = UPS_D + ((ch >> 4) * 2 + (k >> 5)) * 512 + (ch & 15) * 32 + (k & 31); }
            else if (kk_ < 128) { const int k = kk_ - 64; v = p.in[9][((size_t)l * 64 + k) * C_ + ch]; dst = UPS_I + ((ch >> 4) * 2 + (k >> 5)) * 512 + (ch & 15) * 32 + (k & 31); }
            else if (kk_ < 288) { const int k = kk_ - 128; v = p.in[11][((size_t)l * 160 + k) * C_ + ch]; dst = UPS_G + ((ch >> 4) * 5 + (k >> 5)) * 512 + (ch & 15) * 32 + (k & 31); }
            else { const int k = kk_ - 288; v = l > 0 ? p.in[19][((size_t)(l - 1) * 32 + k) * C_ + ch] : 0.f; dst = UPS_V + (ch >> 4) * 512 + (ch & 15) * 32 + k; }
            UPS[(size_t)l * UPS_L + dst] = (bf16_t)(pk_bf16(v, 0.f) & 0xffff);
        }
    }
    if (G == 256) conv_run(cx, p, lds, bx, (CV_P0 - bx + G - 1) / G, G, true);
    else conv_run(cx, p, lds, bx, (4 * 7552 - bx + G - 1) / G, G, false);
}

#define MFMA16(a, b, c) __builtin_amdgcn_mfma_f32_16x16x32_bf16((a), (b), (c), 0, 0, 0)
#define MFMA32(a, b, c) __builtin_amdgcn_mfma_f32_32x32x16_bf16((a), (b), (c), 0, 0, 0)

__device__ __forceinline__ void prep_phase(const Ctx cx, const Params& p, LAS unsigned char* lds, int l) {
    const int tid = cx.tid, wave = tid >> 6, lane = tid & 63, G = cx.G, tl = lane & 15, kq = lane >> 4;
    const bf16_t* PRW = (const bf16_t*)(p.ws + WS_PRW);
    float* SC = (float*)(p.ws + WS_SCAN);
    float* Wo = SC; bf16_t* SB = (bf16_t*)(SC + ARR); bf16_t* KKo = SB, *BBo = SB + ARR, *KMo = SB + 2 * ARR, *Ro = SB + 3 * ARR, *Vo = SB + 4 * ARR;
    bf16_t* VF = (bf16_t*)(p.ws + WS_VFIRST); bf16_t* Gb = (bf16_t*)(p.ws + WS_G);
    const bf16_t* UPS = (const bf16_t*)(p.ws + WS_UPS) + (size_t)l * UPS_L;
    const float* tsm = p.in[6] + (size_t)l * 3360;
    const float* vmix = p.in[18] + (size_t)(l > 0 ? l - 1 : 0) * 32;
    const float* dbias = p.in[8] + l * C_; const float* ibias = p.in[10] + l * C_; const float* kkp = p.in[12] + l * C_; const float* kap = p.in[13] + l * C_;
    const float* vbias = p.in[20] + (size_t)(l > 0 ? l - 1 : 0) * C_;
    LAS u32x4* fr = (LAS u32x4*)lds + wave * 640 + lane;
#pragma unroll 1
    for (int task = cx.bx * 8 + wave; task < 2048; task += G * 8) {
        const int tile = task >> 2, quarter = task & 3;
        const int row = tile * 16 + tl; const bool hasprev = (row & 2047) != 0;
        const unsigned po = prw_row(row), ppo = hasprev ? prw_row(row - 1) : po; const float pm = hasprev ? 1.0f : 0.0f;
#pragma unroll 5
        for (int s = 0; s < 10; ++s) {
            u32x4 w = {0u, 0u, 0u, 0u};
            if (s < 9 || l > 0) {
                const int col = 3072 + 32 * s + 8 * kq;
                f32x4 c0 = unpk4_bf16(*(const u32x2*)(PRW + (po + prw_col(col)))), c1 = unpk4_bf16(*(const u32x2*)(PRW + (po + prw_col(col + 4))));
                const f32x4 q0 = unpk4_bf16(*(const u32x2*)(PRW + (ppo + prw_col(col)))) * pm, q1 = unpk4_bf16(*(const u32x2*)(PRW + (ppo + prw_col(col + 4)))) * pm;
                const float* mup = (s < 9) ? (tsm + col) : (vmix + 8 * kq);
                const f32x4 m0 = *(const f32x4*)mup, m1 = *(const f32x4*)(mup + 4);
                c0 = c0 + (q0 - c0) * m0; c1 = c1 + (q1 - c1) * m1;
                if (s < 2) {
#pragma unroll
                    for (int e = 0; e < 4; ++e) { c0[e] = tanh_fast(c0[e]); c1[e] = tanh_fast(c1[e]); }
                } else if (s >= 4 && s < 9) { c0 = sigm4(c0); c1 = sigm4(c1); }
                const u32x2 a = pk4_bf16(c0), b = pk4_bf16(c1); w.x = a.x; w.y = a.y; w.z = b.x; w.w = b.y;
            }
            fr[s * 64] = w;
        }
#pragma unroll 1
        for (int hh = 0; hh < 4; ++hh) {
            const int cb = quarter * 256 + hh * 64;
            float ssq = 0.f;
#pragma unroll
            for (int ct = 0; ct < 4; ++ct) {
                const int c = cb + 16 * ct + 4 * kq;
                f32x4 k = unpk4_bf16(*(const u32x2*)(PRW + (po + prw_col(1024 + c)))); const f32x4 kp = unpk4_bf16(*(const u32x2*)(PRW + (ppo + prw_col(1024 + c)))) * pm;
                k = k + (kp - k) * *(const f32x4*)(tsm + 1024 + c);
                const f32x4 kk = k * *(const f32x4*)(kkp + c); ssq += dot4(kk, kk);
            }
            ssq += __shfl_xor(ssq, 16); ssq += __shfl_xor(ssq, 32);
            const float inv = 1.0f / fmaxf(sqrtf(ssq), 1e-12f);
            f32x4 xr, xk, xv, xrp, xkp, xvp, xdb, xib, xkk, xka, xvb, xvf, xmr, xmk, xmv; bf16x8 xu[10];
#define PREP_LOAD(ct_) do { const int c_ = cb + 16 * (ct_) + 4 * kq; \
                xr = unpk4_bf16(*(const u32x2*)(PRW + (po + prw_col(c_)))); xk = unpk4_bf16(*(const u32x2*)(PRW + (po + prw_col(1024 + c_)))); xv = unpk4_bf16(*(const u32x2*)(PRW + (po + prw_col(2048 + c_)))); \
                xrp = unpk4_bf16(*(const u32x2*)(PRW + (ppo + prw_col(c_)))); xkp = unpk4_bf16(*(const u32x2*)(PRW + (ppo + prw_col(1024 + c_)))); xvp = unpk4_bf16(*(const u32x2*)(PRW + (ppo + prw_col(2048 + c_)))); \
                xdb = *(const f32x4*)(dbias + c_); xib = *(const f32x4*)(ibias + c_); xkk = *(const f32x4*)(kkp + c_); xka = *(const f32x4*)(kap + c_); \
                xvb = *(const f32x4*)(vbias + c_); xvf = (l > 0) ? unpk4_bf16(*(const u32x2*)(VF + tix(row, c_))) : (f32x4){0.f, 0.f, 0.f, 0.f}; \
                xmr = *(const f32x4*)(tsm + c_); xmk = *(const f32x4*)(tsm + 1024 + c_); xmv = *(const f32x4*)(tsm + 2048 + c_); } while (0)
#define PREP_LOADU(ct_) do { const int t16_ = (cb >> 4) + (ct_); const bf16_t* ub_ = UPS + tl * 32 + 8 * kq; \
                  _Pragma("unroll") for (int s_ = 0; s_ < 2; ++s_) { xu[s_] = *(const bf16x8*)(ub_ + UPS_D + (t16_ * 2 + s_) * 512); xu[2 + s_] = *(const bf16x8*)(ub_ + UPS_I + (t16_ * 2 + s_) * 512); } \
                  _Pragma("unroll") for (int s_ = 0; s_ < 5; ++s_) xu[4 + s_] = *(const bf16x8*)(ub_ + UPS_G + (t16_ * 5 + s_) * 512); \
                  xu[9] = *(const bf16x8*)(ub_ + UPS_V + t16_ * 512); } while (0)
            PREP_LOAD(0); PREP_LOADU(0);
#pragma unroll 1
            for (int ct = 0; ct < 4; ++ct) {
                const int ch0 = cb + 16 * ct;
                f32x4 aw = {0.f, 0.f, 0.f, 0.f}, aa = aw, ag = aw, avv = aw;
#pragma unroll
                for (int s = 0; s < 2; ++s) aw = MFMA16(xu[s], __builtin_bit_cast(bf16x8, fr[s * 64]), aw);
#pragma unroll
                for (int s = 0; s < 2; ++s) aa = MFMA16(xu[2 + s], __builtin_bit_cast(bf16x8, fr[(2 + s) * 64]), aa);
#pragma unroll
                for (int s = 0; s < 5; ++s) ag = MFMA16(xu[4 + s], __builtin_bit_cast(bf16x8, fr[(4 + s) * 64]), ag);
                if (l > 0) avv = MFMA16(xu[9], __builtin_bit_cast(bf16x8, fr[9 * 64]), avv);
                asm volatile("" ::: "memory"); if (ct < 3) PREP_LOADU(ct + 1);
                const int c = ch0 + 4 * kq; const unsigned o = tix(row, c);
                const f32x4 r = xr + (xrp * pm - xr) * xmr, k = xk + (xkp * pm - xk) * xmk; f32x4 v = xv + (xvp * pm - xv) * xmv;
                *(u32x2*)(Ro + o) = pk4_bf16(r);
                const f32x4 sg = sigm4(xdb + aw);
                f32x4 dec;
#pragma unroll
                for (int e = 0; e < 4; ++e) dec[e] = __expf(-0.6065306597126334f * sg[e]);
                *(f32x4*)(Wo + o) = dec;
                const f32x4 a = sigm4(xib + aa);
                if (l > 0) v = v + (xvf - v) * sigm4(xvb + avv);
                else *(u32x2*)(VF + o) = pk4_bf16(v);
                *(u32x2*)(Vo + o) = pk4_bf16(v);
                const f32x4 kk = k * xkk * inv;
                *(u32x2*)(KKo + o) = pk4_bf16(kk); *(u32x2*)(BBo + o) = pk4_bf16(kk * a);
                const f32x4 km = k * (1.0f + (a - 1.0f) * xka);
                *(u32x2*)(KMo + o) = pk4_bf16(km);
                *(u32x2*)(Gb + o) = pk4_bf16(ag);
                asm volatile("" ::: "memory"); if (ct < 3) PREP_LOAD(ct + 1);
            }
#undef PREP_LOADU
#undef PREP_LOAD
        }
    }
}

__device__ __forceinline__ bf16x8 pack8(const f32x16& x, const int s) {
    u32x4 w; w.x = pk_bf16(x[8 * s], x[8 * s + 1]); w.y = pk_bf16(x[8 * s + 2], x[8 * s + 3]); w.z = pk_bf16(x[8 * s + 4], x[8 * s + 5]); w.w = pk_bf16(x[8 * s + 6], x[8 * s + 7]);
    return __builtin_bit_cast(bf16x8, w);
}
__device__ __forceinline__ void attn_task(const Params& p, int l, int task, int lane) {
    const bf16_t* QB = (const bf16_t*)(p.ws + WS_QB); const bf16_t* KB = (const bf16_t*)(p.ws + WS_KB); const bf16_t* VT = (const bf16_t*)(p.ws + WS_VT); bf16_t* YA = (bf16_t*)(p.ws + WS_YA);
    const int qt = task & 63, head = (task >> 6) & 15, b = task >> 10;
    const int c = lane & 31, h = lane >> 5, kvh = head >> 2;
    const float slope = exp2f(-0.5f * (float)(head + 1)); const float sink = p.in[5][l * 16 + head];
    const int q0 = qt * 32; const size_t rb = (size_t)b * T_;
    bf16x8 qf[4];
#pragma unroll
    for (int dd = 0; dd < 4; ++dd) qf[dd] = *(const bf16x8*)(QB + (rb + q0 + c) * 1024 + head * 64 + 16 * dd + 8 * h);
    f32x16 S[5];
#pragma unroll
    for (int kt = 0; kt < 5; ++kt) {
        const int key = q0 - 128 + 32 * kt + c, keyc = key < 0 ? 0 : key;
        f32x16 acc;
#pragma unroll
        for (int e = 0; e < 16; ++e) acc[e] = 0.f;
#pragma unroll
        for (int dd = 0; dd < 4; ++dd) acc = MFMA32(*(const bf16x8*)(KB + ((size_t)((b * 4 + kvh) * 4 + dd) * 2048 + keyc) * 16 + 8 * h), qf[dd], acc);
        S[kt] = acc;
    }
    const int t = q0 + c; float mx = sink;
#pragma unroll
    for (int kt = 0; kt < 5; ++kt)
#pragma unroll
        for (int e = 0; e < 16; ++e) {
            const int s = q0 - 128 + 32 * kt + (e & 3) + 8 * (e >> 2) + 4 * h, dist = t - s;
            const bool valid = (dist >= 0) && (dist < 128) && (s >= 0);
            const float val = valid ? (S[kt][e] * 0.125f - slope * (float)dist) : -INFINITY;
            S[kt][e] = val; mx = fmaxf(mx, val);
        }
    mx = fmaxf(mx, __shfl_xor(mx, 32));
    float sum = 0.f;
#pragma unroll
    for (int kt = 0; kt < 5; ++kt)
#pragma unroll
        for (int e = 0; e < 16; ++e) { const float pv = __expf(S[kt][e] - mx); S[kt][e] = pv; sum += pv; }
    sum += __shfl_xor(sum, 32);
    const float inv = 1.0f / (sum + __expf(sink - mx));
    f32x16 O[2];
#pragma unroll
    for (int e = 0; e < 16; ++e) { O[0][e] = 0.f; O[1][e] = 0.f; }
#pragma unroll
    for (int kt = 0; kt < 5; ++kt)
#pragma unroll
        for (int s = 0; s < 2; ++s) {
            const bf16x8 pf = pack8(S[kt], s);
            const int kb = q0 - 128 + 32 * kt + 16 * s + 4 * h; const int k_lo = kb < 0 ? 0 : kb, k_hi = kb + 8 < 0 ? 0 : kb + 8;
#pragma unroll
            for (int dt = 0; dt < 2; ++dt) {
                const bf16_t* vb = VT + (size_t)(b * 4 + kvh) * (512 * 256) + (32 * dt + c) * 4;
                const u32x2 lo = *(const u32x2*)(vb + (k_lo >> 2) * 256), hi = *(const u32x2*)(vb + (k_hi >> 2) * 256);
                u32x4 w; w.x = lo.x; w.y = lo.y; w.z = hi.x; w.w = hi.y;
                O[dt] = MFMA32(__builtin_bit_cast(bf16x8, w), pf, O[dt]);
            }
        }
#pragma unroll
    for (int dt = 0; dt < 2; ++dt)
#pragma unroll
        for (int g4 = 0; g4 < 4; ++g4) {
            const int d = 32 * dt + 8 * g4 + 4 * h;
            f32x4 v = {O[dt][4 * g4] * inv, O[dt][4 * g4 + 1] * inv, O[dt][4 * g4 + 2] * inv, O[dt][4 * g4 + 3] * inv};
            *(u32x2*)(YA + tixa(rb + q0 + c, head * 64 + d, 1024)) = pk4_bf16(v);
        }
}
__device__ __forceinline__ void attn_phase(const Ctx cx, const Params& p, int l) {
    const int wave = cx.tid >> 6, lane = cx.tid & 63;
    for (int task = cx.bx * 8 + wave; task < 4096; task += cx.G * 8) attn_task(p, l, task, lane);
}

struct AttnT { int b, head, kvh, q0, c, h; float slope, sink; size_t rb; };
__device__ __forceinline__ void at_decode(AttnT& t, const Params& p, int l, int task, int lane) {
    const int qt = task & 63; t.head = (task >> 6) & 15; t.b = task >> 10; t.c = lane & 31; t.h = lane >> 5; t.kvh = t.head >> 2;
    t.slope = exp2f(-0.5f * (float)(t.head + 1)); t.sink = p.in[5][l * 16 + t.head]; t.q0 = qt * 32; t.rb = (size_t)t.b * T_;
}
__device__ __forceinline__ void at_load_q(const Params& p, const AttnT& t, bf16x8 (&qf)[4]) {
    const bf16_t* QB = (const bf16_t*)(p.ws + WS_QB);
#pragma unroll
    for (int dd = 0; dd < 4; ++dd) qf[dd] = *(const bf16x8*)(QB + (t.rb + t.q0 + t.c) * 1024 + t.head * 64 + 16 * dd + 8 * t.h);
}
template <int BASE> __device__ __forceinline__ void at_load_k(const Params& p, const AttnT& t, int kt, u32x4 (&buf)[4]) {
    const bf16_t* KB = (const bf16_t*)(p.ws + WS_KB);
    const int key = t.q0 - 128 + 32 * kt + t.c, keyc = key < 0 ? 0 : key;
#pragma unroll
    for (int dd = 0; dd < 4; ++dd) buf[BASE + dd] = *(const u32x4*)(KB + ((size_t)((t.b * 4 + t.kvh) * 4 + dd) * 2048 + keyc) * 16 + 8 * t.h);
}
template <int BASE> __device__ __forceinline__ void at_qk(const bf16x8 (&qf)[4], const u32x4 (&buf)[4], f32x16& S) {
    f32x16 acc;
#pragma unroll
    for (int e = 0; e < 16; ++e) acc[e] = 0.f;
#pragma unroll
    for (int dd = 0; dd < 4; ++dd) acc = MFMA32(__builtin_bit_cast(bf16x8, buf[BASE + dd]), qf[dd], acc);
    S = acc;
}
__device__ __forceinline__ float at_softmax_a(const AttnT& t, f32x16 (&S)[5]) {
    const int tq = t.q0 + t.c; float mx = t.sink;
#pragma unroll
    for (int kt = 0; kt < 5; ++kt)
#pragma unroll
        for (int e = 0; e < 16; ++e) {
            const int s = t.q0 - 128 + 32 * kt + (e & 3) + 8 * (e >> 2) + 4 * t.h, dist = tq - s;
            const bool valid = (dist >= 0) && (dist < 128) && (s >= 0);
            const float val = valid ? (S[kt][e] * 0.125f - t.slope * (float)dist) : -INFINITY;
            S[kt][e] = val; mx = fmaxf(mx, val);
        }
    return fmaxf(mx, __shfl_xor(mx, 32));
}
__device__ __forceinline__ float at_softmax_b(const AttnT& t, f32x16 (&S)[5], float mx) {
    float sum = 0.f;
#pragma unroll
    for (int kt = 0; kt < 5; ++kt)
#pragma unroll
        for (int e = 0; e < 16; ++e) { const float pv = __expf(S[kt][e] - mx); S[kt][e] = pv; sum += pv; }
    sum += __shfl_xor(sum, 32);
    return 1.0f / (sum + __expf(t.sink - mx));
}
template <int BASE> __device__ __forceinline__ void at_load_v(const Params& p, const AttnT& t, int kt, u32x4 (&buf)[4]) {
    const bf16_t* VT = (const bf16_t*)(p.ws + WS_VT);
#pragma unroll
    for (int s = 0; s < 2; ++s) {
        const int kb = t.q0 - 128 + 32 * kt + 16 * s + 4 * t.h; const int k_lo = kb < 0 ? 0 : kb, k_hi = kb + 8 < 0 ? 0 : kb + 8;
#pragma unroll
        for (int dt = 0; dt < 2; ++dt) {
            const bf16_t* vb = VT + (size_t)(t.b * 4 + t.kvh) * (512 * 256) + (32 * dt + t.c) * 4;
            const u32x2 lo = *(const u32x2*)(vb + (k_lo >> 2) * 256), hi = *(const u32x2*)(vb + (k_hi >> 2) * 256);
            u32x4 w; w.x = lo.x; w.y = lo.y; w.z = hi.x; w.w = hi.y; buf[BASE + 2 * s + dt] = w;
        }
    }
}
template <int BASE> __device__ __forceinline__ void at_pv(const f32x16& Skt, const u32x4 (&buf)[4], f32x16 (&O)[2]) {
#pragma unroll
    for (int s = 0; s < 2; ++s) {
        const bf16x8 pf = pack8(Skt, s);
#pragma unroll
        for (int dt = 0; dt < 2; ++dt) O[dt] = MFMA32(__builtin_bit_cast(bf16x8, buf[BASE + 2 * s + dt]), pf, O[dt]);
    }
}
__device__ __forceinline__ void at_store(const Params& p, const AttnT& t, const f32x16 (&O)[2], float inv) {
    bf16_t* YA = (bf16_t*)(p.ws + WS_YA);
#pragma unroll
    for (int dt = 0; dt < 2; ++dt)
#pragma unroll
        for (int g4 = 0; g4 < 4; ++g4) {
            const int d = 32 * dt + 8 * g4 + 4 * t.h;
            f32x4 v = {O[dt][4 * g4] * inv, O[dt][4 * g4 + 1] * inv, O[dt][4 * g4 + 2] * inv, O[dt][4 * g4 + 3] * inv};
            *(u32x2*)(YA + tixa(t.rb + t.q0 + t.c, t.head * 64 + d, 1024)) = pk4_bf16(v);
        }
}

constexpr int SC_CH = 32, SC_STEP = 336;
__device__ __forceinline__ void scan_phase(const Ctx cx, const Params& p, LAS unsigned char* lds, int l, bool fuse_attn) {
    const int tid = cx.tid, wave = __builtin_amdgcn_readfirstlane(tid >> 6), lane = tid & 63, G = cx.G;
    const float* SC = (const float*)(p.ws + WS_SCAN); bf16_t* YRAW = (bf16_t*)(p.ws + WS_PRW);
    LAS float* ring = (LAS float*)lds;
    for (int tb = cx.bx; tb < 256; tb += G) {
        const int bh = tb >> 2, q = tb & 3, b = bh >> 4, hd = bh & 15;
        const size_t rowb = (size_t)b * T_; const int cbase = hd * 64;
        __syncthreads();
        if (tid >= 256) {
            int ht = tid - 256; asm volatile("" : "+v"(ht));
            const bf16_t* SBh = (const bf16_t*)(SC + ARR);
            const unsigned gw0 = tix((int)rowb + (ht >> 4), cbase + 4 * (ht & 15)), lw0 = (unsigned)((ht >> 4) * SC_STEP + 64 + 4 * (ht & 15));
            const unsigned gb0 = tix((int)rowb + (ht >> 3), cbase + 8 * (ht & 7)), lb0 = (unsigned)((ht >> 3) * SC_STEP + 8 * (ht & 7));
            unsigned gv, lv;
#define gw(i) (gw0 + (unsigned)(i) * 16384u)
#define lw(i) (lw0 + (unsigned)(i) * (16u * SC_STEP))
#define gb(i) (gb0 + (unsigned)(i) * (unsigned)ARR)
#define lb(i) (lb0 + ((i) == 0 ? 0u : 64u + 64u * (unsigned)(i)))
            { const int j = ht & 63, step = j >> 1, c8 = j & 1; gv = 4u * (unsigned)ARR + tix((int)rowb + step, cbase + 16 * q + 8 * c8); lv = (unsigned)(step * SC_STEP + 320 + 8 * c8); }
            const bool hasv = ht < 64;
            f32x4 tw[2]; u32x4 tb[4], tv = {0u, 0u, 0u, 0u};
#define SCAN_LOAD(cofs_) do { _Pragma("unroll") for (int i = 0; i < 2; ++i) tw[i] = *(const f32x4*)(SC + (size_t)(gw(i) + (cofs_))); \
                _Pragma("unroll") for (int i = 0; i < 4; ++i) tb[i] = *(const u32x4*)(SBh + (size_t)(gb(i) + (cofs_))); \
                if (hasv) tv = *(const u32x4*)(SBh + (size_t)(gv + (cofs_))); } while (0)
#define SCAN_PUT8(dst_, w_) do { f32x4 lo_, hi_; lo_[0] = __uint_as_float((w_).x << 16); lo_[1] = __uint_as_float((w_).x & 0xffff0000u); lo_[2] = __uint_as_float((w_).y << 16); lo_[3] = __uint_as_float((w_).y & 0xffff0000u); \
                hi_[0] = __uint_as_float((w_).z << 16); hi_[1] = __uint_as_float((w_).z & 0xffff0000u); hi_[2] = __uint_as_float((w_).w << 16); hi_[3] = __uint_as_float((w_).w & 0xffff0000u); \
                *(LAS f32x4*)(dst_) = lo_; *(LAS f32x4*)((dst_) + 4) = hi_; } while (0)
#define SCAN_STORE(buf_) do { _Pragma("unroll") for (int i = 0; i < 2; ++i) *(LAS f32x4*)((buf_) + lw(i)) = tw[i]; \
                _Pragma("unroll") for (int i = 0; i < 4; ++i) SCAN_PUT8((buf_) + lb(i), tb[i]); \
                if (hasv) SCAN_PUT8((buf_) + lv, tv); } while (0)
            SCAN_LOAD(0u);
            SCAN_STORE(ring);
            SCAN_LOAD((unsigned)SC_CH * C_);
            __syncthreads();
#define SCAN_HB(c_) do { const int cc_ = (c_); if (cc_ < T_ / SC_CH) { LAS float* hb_ = ring + (cc_ & 1) * SC_CH * SC_STEP; SCAN_STORE(hb_); \
                if (cc_ + 1 < T_ / SC_CH) { const unsigned cofs_ = (unsigned)(cc_ + 1) * SC_CH * C_; SCAN_LOAD(cofs_); } } __syncthreads(); } while (0)
            const int hwid = cx.bx * 4 + (wave - 4);
            const bool act = fuse_attn;
#pragma unroll 1
            for (int grp = 0; grp < 4; ++grp) {
                const int cb = 1 + grp * 16;
                AttnT at; bf16x8 qf[4]; u32x4 ab[4]; f32x16 S[5]; f32x16 O[2]; float inv = 0.f, mx = 0.f;
                int task_ = grp * 1024 + hwid; asm volatile("" : "+s"(task_));
                int ln_ = lane; asm volatile("" : "+v"(ln_));
                if (act) { at_decode(at, p, l, task_, ln_); at_load_q(p, at, qf); at_load_k<0>(p, at, 0, ab); }
                SCAN_HB(cb + 0);
                if (act) { at_qk<0>(qf, ab, S[0]); at_load_k<0>(p, at, 1, ab); }
                SCAN_HB(cb + 1);
                if (act) { at_qk<0>(qf, ab, S[1]); at_load_k<0>(p, at, 2, ab); }
                SCAN_HB(cb + 2);
                if (act) { at_qk<0>(qf, ab, S[2]); at_load_k<0>(p, at, 3, ab); }
                SCAN_HB(cb + 3);
                if (act) { at_qk<0>(qf, ab, S[3]); at_load_k<0>(p, at, 4, ab); }
                SCAN_HB(cb + 4);
                if (act) { at_qk<0>(qf, ab, S[4]); }
                SCAN_HB(cb + 5);
                if (act) { mx = at_softmax_a(at, S); }
                SCAN_HB(cb + 6);
                if (act) { inv = at_softmax_b(at, S, mx); at_load_v<0>(p, at, 0, ab); }
                SCAN_HB(cb + 7);
                if (act) {
#pragma unroll
                    for (int e = 0; e < 16; ++e) { O[0][e] = 0.f; O[1][e] = 0.f; }
                    at_pv<0>(S[0], ab, O); at_load_v<0>(p, at, 1, ab); }
                SCAN_HB(cb + 8);
                if (act) { at_pv<0>(S[1], ab, O); at_load_v<0>(p, at, 2, ab); }
                SCAN_HB(cb + 9);
                if (act) { at_pv<0>(S[2], ab, O); at_load_v<0>(p, at, 3, ab); }
                SCAN_HB(cb + 10);
                if (act) { at_pv<0>(S[3], ab, O); at_load_v<0>(p, at, 4, ab); }
                SCAN_HB(cb + 11);
                if (act) { at_pv<0>(S[4], ab, O); at_store(p, at, O, inv); }
                SCAN_HB(cb + 12);
                SCAN_HB(cb + 13);
                SCAN_HB(cb + 14);
                SCAN_HB(cb + 15);
            }
#undef SCAN_HB
#undef gw
#undef lw
#undef gb
#undef lb
#undef SCAN_LOAD
#undef SCAN_PUT8
#undef SCAN_STORE
        } else {
            int lane_s = lane; asm volatile("" : "+v"(lane_s));
            const int jg = lane_s & 15, ri = lane_s >> 4;
            f32x2 Sa = {0.f, 0.f}, Sb = {0.f, 0.f};
            __builtin_amdgcn_s_setprio(3);
            __syncthreads();
            for (int c = 0; c < T_ / SC_CH; ++c) {
                const LAS float* base = ring + (c & 1) * SC_CH * SC_STEP;
                bf16_t* yp = YRAW + tix((int)rowb + c * SC_CH + jg, cbase + 16 * q + 4 * wave + ri);
                const LAS float* lp = base + 4 * jg; const LAS float* vp = base + 320 + 4 * wave + ri;
                f32x4 kk = *(const LAS f32x4*)(lp), w = *(const LAS f32x4*)(lp + 64), bb = *(const LAS f32x4*)(lp + 128), km = *(const LAS f32x4*)(lp + 192), r = *(const LAS f32x4*)(lp + 256);
                float v = vp[0];
#pragma unroll 1
                for (int g16 = 0; g16 < SC_CH / 16; ++g16) {
                    float ykeep = 0.f;
#pragma unroll
                    for (int s16 = 0; s16 < 16; ++s16) {
                        f32x4 nkk = kk, nw = w, nbb = bb, nkm = km, nr = r; float nv = v;
                        if (s16 < 15 || g16 + 1 < SC_CH / 16) {
                            const LAS float* np = lp + (g16 * 16 + s16 + 1) * SC_STEP;
                            nkk = *(const LAS f32x4*)(np); nw = *(const LAS f32x4*)(np + 64); nbb = *(const LAS f32x4*)(np + 128); nkm = *(const LAS f32x4*)(np + 192); nr = *(const LAS f32x4*)(np + 256);
                            nv = vp[(g16 * 16 + s16 + 1) * SC_STEP];
                        }
                        const f32x2 dd = Sa * kk.xy + Sb * kk.zw;
                        const float d = red16(dd.x + dd.y);
                        const f32x2 ta = km.xy * v - bb.xy * d, tb2 = km.zw * v - bb.zw * d;
                        Sa = Sa * w.xy + ta; Sb = Sb * w.zw + tb2;
                        const f32x2 yy = Sa * r.xy + Sb * r.zw;
                        const float y = red16(yy.x + yy.y);
                        ykeep = (jg == s16) ? y : ykeep;
                        kk = nkk; w = nw; bb = nbb; km = nkm; r = nr; v = nv;
                    }
                    yp[g16 * 16384] = (bf16_t)(pk_bf16(ykeep, 0.f) & 0xffffu);
                }
                __syncthreads();
            }
            __builtin_amdgcn_s_setprio(0);
        }
    }
}

__device__ __forceinline__ void post_phase(const Ctx cx, const Params& p, int l) {
    const int wave = cx.tid >> 6, lane = cx.tid & 63, jg = lane & 15;
    const bf16_t* YRAW = (const bf16_t*)(p.ws + WS_PRW); const float* SC = (const float*)(p.ws + WS_SCAN);
    const bf16_t* SB = (const bf16_t*)(SC + ARR); const bf16_t* KMi = SB + 2 * ARR, *Ri = SB + 3 * ARR, *Vi = SB + 4 * ARR; const bf16_t* Gb = (const bf16_t*)(p.ws + WS_G); bf16_t* YR = (bf16_t*)(p.ws + WS_YR);
    const float* rk = p.in[14] + l * C_; const float* lw = p.in[15] + l * C_; const float* lb = p.in[16] + l * C_;
    const int NIT = M_ * 16 / 4, stride = cx.G * 8;
    int it = cx.bx * 8 + wave;
    f32x4 ny = {0.f, 0.f, 0.f, 0.f}; u32x2 nr = {0u, 0u}, nkm = nr, nv = nr, ng = nr;
#define POST_LOAD(it_) do { const int row_ = ((it_) >> 4) * 4 + (lane >> 4), c_ = ((it_) & 15) * 64 + 4 * jg; const unsigned o_ = tix(row_, c_); \
        ny = unpk4_bf16(*(const u32x2*)(YRAW + o_)); nr = *(const u32x2*)(Ri + o_); nkm = *(const u32x2*)(KMi + o_); nv = *(const u32x2*)(Vi + o_); ng = *(const u32x2*)(Gb + o_); } while (0)
    if (it < NIT) POST_LOAD(it);
#pragma unroll 1
    for (; it < NIT; it += stride) {
        const int row = (it >> 4) * 4 + (lane >> 4), hd = it & 15, c = hd * 64 + 4 * jg;
        const f32x4 y = ny; const u32x2 pr_ = nr, pkm = nkm, pv_ = nv, pg = ng;
        if (it + stride < NIT) POST_LOAD(it + stride);
        const f32x4 rkc = *(const f32x4*)(rk + c), lwc = *(const f32x4*)(lw + c), lbc = *(const f32x4*)(lb + c);
        const float mean = red16((y[0] + y[1]) + (y[2] + y[3])) * (1.0f / 64.0f);
        const f32x4 d = y - mean; const float var = red16(dot4(d, d)) * (1.0f / 64.0f); const float rstd = rsqrtf(var + LNX_EPS);
        const f32x4 r = unpk4_bf16(pr_), km = unpk4_bf16(pkm), v = unpk4_bf16(pv_), g = unpk4_bf16(pg);
        const float bonus = red16(dot4(r * km, rkc));
        const f32x4 outv = ((d * rstd) * lwc + lbc + bonus * v) * g;
        *(u32x2*)(YR + tixa((size_t)row, c, 1024)) = pk4_bf16(outv);
    }
#undef POST_LOAD
}

__device__ __forceinline__ void final_phase(const Ctx cx, const Params& p) {
    const bf16_t* XB = (const bf16_t*)(p.ws + WS_XB); const float* ss = (const float*)(p.ws + WS_SS) + (size_t)8 * M_ * 32; const float* g = p.in[3];
    const int wave = cx.tid >> 6, lane = cx.tid & 63, stride = cx.G * 8;
    int row = cx.bx * 8 + wave; u32x2 nx[8]; float nsq = 0.f;
    f32x4 gv[8]; int pc[8];
#pragma unroll
    for (int i = 0; i < 8; ++i) { const int lc = (lane + 64 * i) * 4; gv[i] = *(const f32x4*)(g + lc); pc[i] = (lc & ~31) + 8 * ((lc >> 2) & 3) + 4 * ((lc >> 4) & 1); }
    if (row < M_) { nsq = ss[(size_t)row * 32 + (lane & 31)];
#pragma unroll
        for (int i = 0; i < 8; ++i) nx[i] = *(const u32x2*)(XB + tixa((size_t)row, pc[i], D_)); }
#pragma unroll 1
    for (; row < M_; row += stride) {
        u32x2 v[8]; float sq = nsq;
#pragma unroll
        for (int i = 0; i < 8; ++i) v[i] = nx[i];
        if (row + stride < M_) { nsq = ss[(size_t)(row + stride) * 32 + (lane & 31)];
#pragma unroll
            for (int i = 0; i < 8; ++i) nx[i] = *(const u32x2*)(XB + tixa((size_t)(row + stride), pc[i], D_)); }
#pragma unroll
        for (int o = 16; o >= 1; o >>= 1) sq += __shfl_xor(sq, o);
        const float rs = rsqrtf(sq * (1.0f / 2048.0f) + NORM_EPS);
        f32x4* orow = (f32x4*)(p.out + (size_t)row * D_);
#pragma unroll
        for (int i = 0; i < 8; ++i) orow[lane + 64 * i] = unpk4_bf16(v[i]) * rs * gv[i];
    }
}

#define XB_TMO      128
#define XB_XCNT(j)  (256  + 64 * (j))
#define XB_XSUB(j)  (1280 + 64 * (j))
#define XB_XGEN(j)  (2304 + 64 * (j))
#define XB_TOP      3328
#define XB_TOPGEN   3392
#define XCD_BAR_WORDS 3456
#define XB_SPIN_CAP (1u << 20)
__device__ __forceinline__ unsigned xb_ld(unsigned* p)              { return __hip_atomic_load(p, __ATOMIC_RELAXED, __HIP_MEMORY_SCOPE_AGENT); }
__device__ __forceinline__ unsigned xb_add(unsigned* p, unsigned v) { return __hip_atomic_fetch_add(p, v, __ATOMIC_RELAXED, __HIP_MEMORY_SCOPE_AGENT); }
__device__ __forceinline__ unsigned xb_xcc_id() { return (unsigned)__builtin_amdgcn_s_getreg((3 << 11) | 20) & 0xFu; }
#define XB_SPIN(cond, bar) do { unsigned _sp = 0; while (cond) { __builtin_amdgcn_s_sleep(1); \
    if ((++_sp & 255u) == 0u) { if (xb_ld(&(bar)[XB_TMO])) break; if (_sp > XB_SPIN_CAP) { atomicAdd(&(bar)[XB_TMO], 1u); break; } } } } while (0)
struct XcdBarrier { unsigned* bar; unsigned x; volatile LAS unsigned* st; };
__device__ __forceinline__ XcdBarrier xcd_barrier_post(unsigned* bar, volatile LAS unsigned* st, bool leader) {
    XcdBarrier b; b.bar = bar; b.x = xb_xcc_id(); b.st = st;
    if (leader) (void)xb_add(&bar[XB_XCNT(b.x)], 1u);
    return b;
}
__device__ __forceinline__ void xcd_barrier_complete(unsigned* bar, unsigned x, unsigned& nloc, unsigned& nx) {
    const unsigned G = gridDim.x * gridDim.y * gridDim.z;
    unsigned sum, cnt, mine, sp = 0u;
    for (;;) {
        sum = 0u; cnt = 0u; mine = 0u;
#pragma unroll
        for (unsigned j = 0; j < 16; ++j) { const unsigned c = xb_ld(&bar[XB_XCNT(j)]); sum += c; cnt += (c > 0u) ? 1u : 0u; mine = (j == x) ? c : mine; }
        if (sum == G) break;
        __builtin_amdgcn_s_sleep(1);
        if ((++sp & 255u) == 0u) { if (xb_ld(&bar[XB_TMO])) break; if (sp > XB_SPIN_CAP) { atomicAdd(&bar[XB_TMO], 1u); break; } }
    }
    nloc = mine > 0u ? mine : 1u; nx = cnt > 0u ? cnt : 1u;
}
__device__ __forceinline__ void xcd_barrier(const XcdBarrier& b, bool leader) {
    asm volatile("s_waitcnt vmcnt(0)" ::: "memory");
    __syncthreads();
    if (leader) {
        unsigned* bar = b.bar;
        __builtin_amdgcn_s_waitcnt(0);
        unsigned nloc = b.st[0], nx = b.st[1];
        if (nloc == 0u) { xcd_barrier_complete(bar, b.x, nloc, nx); b.st[0] = nloc; b.st[1] = nx; }
        const unsigned old = xb_add(&bar[XB_XSUB(b.x)], 1u);
        const unsigned gen = old / nloc;
        if (old + 1u == (gen + 1u) * nloc) {
            __builtin_amdgcn_fence(__ATOMIC_RELEASE, "agent");
            asm volatile("s_waitcnt vmcnt(0)" ::: "memory");
            const unsigned og = xb_add(&bar[XB_TOP], 1u);
            const unsigned tg = og / nx;
            if (og + 1u == (tg + 1u) * nx) xb_add(&bar[XB_TOPGEN], 1u);
            else XB_SPIN(xb_ld(&bar[XB_TOPGEN]) == tg, bar);
            __builtin_amdgcn_fence(__ATOMIC_ACQUIRE, "agent");
            xb_add(&bar[XB_XGEN(b.x)], 1u);
            asm volatile("s_waitcnt vmcnt(0)" ::: "memory");
        } else {
            XB_SPIN(xb_ld(&bar[XB_XGEN(b.x)]) == gen, bar);
            __builtin_amdgcn_fence(__ATOMIC_ACQUIRE, "agent");
            asm volatile("s_waitcnt vmcnt(0)" ::: "memory");
        }
    }
    __syncthreads();
}

constexpr int N_PHASES = 34;
__global__ void __launch_bounds__(512, 2) fwd_kernel(Params p_arg) {
    extern __shared__ __attribute__((aligned(16))) unsigned char smem[];
    LAS unsigned char* lds = (LAS unsigned char*)smem;
    cg::grid_group grid = cg::this_grid();
    const int ph_lo = p_arg.ph_lo, ph_hi = p_arg.ph_hi;
    volatile LAS unsigned* bst = (volatile LAS unsigned*)(lds + LDS_STAGE);
    const int wave_id_ = __builtin_amdgcn_readfirstlane((int)threadIdx.x >> 6);
    if (threadIdx.x == 0) { bst[0] = 0u; bst[1] = 0u; }
    __syncthreads();
    XcdBarrier xbar; xbar.bar = (unsigned*)(p_arg.ws + WS_BAR); xbar.x = 0; xbar.st = bst;
    if (ph_hi - ph_lo > 1) xbar = xcd_barrier_post((unsigned*)(p_arg.ws + WS_BAR), bst, threadIdx.x == 0);
    for (int ph = ph_lo; ph < ph_hi; ++ph) {
        if (ph > ph_lo) { if (ph_lo < 0) grid.sync(); else { int l0_; asm volatile("v_mbcnt_lo_u32_b32 %0, -1, 0\n\tv_mbcnt_hi_u32_b32 %0, -1, %0" : "=v"(l0_)); xcd_barrier(xbar, wave_id_ == 0 && l0_ == 0); } }
        Ctx cx; { int ln_; asm volatile("v_mbcnt_lo_u32_b32 %0, -1, 0\n\tv_mbcnt_hi_u32_b32 %0, -1, %0" : "=v"(ln_));
        int t_ = wave_id_ * 64 + ln_, b_ = blockIdx.x, g_ = gridDim.x; asm volatile("" : "+v"(t_)); asm volatile("" : "+s"(b_)); asm volatile("" : "+s"(g_)); cx.tid = t_; cx.bx = b_; cx.G = g_; }
        const Params& p = p_arg;
        const int G = cx.G, bx = cx.bx;
        unsigned char* ws = p.ws;
        const bf16_t* XB = (const bf16_t*)(ws + WS_XB); float* SS = (float*)(ws + WS_SS); float* XRES = (float*)(ws + WS_XRES);
        if (ph == 0) { for (int r_ = 0; r_ < REP_P0; ++r_) p0_prologue(cx, p, lds); continue; }
        if (ph == N_PHASES - 1) { final_phase(cx, p); continue; }
        const int l = (ph - 1) >> 3, k = (ph - 1) & 7;
        const bf16_t* WL = (const bf16_t*)(ws + WS_W) + (size_t)l * LSTRIDE;
        pg8::StaticOrder S;
        if (k == 0) {
            pg8::Gemm g{XB, WL + OFF_WIN, M_, NP_, D_}; S.init(M_, NP_, G, bx);
            rs_table_fill(cx, lds, S, SS + (size_t)(2 * l) * M_ * 32);
            EpiInProj E{(const LAS float*)(lds + LDS_RST), (bf16_t*)(ws + WS_QB), (bf16_t*)(ws + WS_KB), (bf16_t*)(ws + WS_VT), (bf16_t*)(ws + WS_PRW), (bf16_t*)(ws + WS_SG)};
            for (int r_ = 0; r_ < REP_INPROJ; ++r_) pg8::gemm_phase(cx, lds, g, S, E);
            if (G == 256 && bx >= 128 && l < 3) conv_run(cx, p, lds, (l + 1) * 7552 + (bx - 128), CV_SLOT, 128, false);
        } else if (k == 1) { for (int r_ = 0; r_ < REP_PREP; ++r_) prep_phase(cx, p, lds, l); if (G != 256) attn_phase(cx, p, l); }
        else if (k == 2) { for (int r_ = 0; r_ < REP_SCAN; ++r_) scan_phase(cx, p, lds, l, G == 256); }
        else if (k == 3) { for (int r_ = 0; r_ < REP_POST; ++r_) post_phase(cx, p, l); }
        else if (k == 4) {
            pg8::PairOrder SP; SP.init(M_, D_, G, bx);
            pg8::Gemm g{(const bf16_t*)(ws + WS_YA), WL + OFF_WBA, 2 * M_, 2 * D_, C_};
            EpiBranchPair E{(const bf16_t*)(ws + WS_SG), (bf16_t*)(ws + WS_MRG)};
            pg8::gemm_phase(cx, lds, g, SP, E);
        } else if (k == 5) {
            pg8::Gemm g{(const bf16_t*)(ws + WS_MRG), WL + OFF_WO, M_, D_, D_}; S.init(M_, D_, G, bx);
            EpiResid E{(bf16_t*)(ws + WS_XB), SS + (size_t)(2 * l + 1) * M_ * 32};
            pg8::gemm_phase(cx, lds, g, S, E);
        } else if (k == 6) {
            pg8::Gemm g{XB, WL + OFF_WGU, M_, 2 * FH_, D_}; S.init(M_, 2 * FH_, G, bx);
            rs_table_fill(cx, lds, S, SS + (size_t)(2 * l + 1) * M_ * 32);
            EpiFFN E{(const LAS float*)(lds + LDS_RST), (bf16_t*)(ws + WS_PRW)};
            for (int r_ = 0; r_ < REP_GU; ++r_) pg8::gemm_phase(cx, lds, g, S, E);
            if (G == 256 && bx >= 128 && l < 3) conv_run(cx, p, lds, (l + 1) * 7552 + CV_Q + (bx - 128), CV_SLOT, 128, false);
        } else {
            pg8::Gemm g{(const bf16_t*)(ws + WS_PRW), WL + OFF_WD, M_, D_, FH_}; S.init(M_, D_, G, bx);
            EpiResid E{(bf16_t*)(ws + WS_XB), SS + (size_t)(2 * l + 2) * M_ * 32};
            pg8::gemm_phase(cx, lds, g, S, E);
        }
    }
}

extern "C" void kernel_launch(void* const* d_in, const int* in_sizes, int n_in, void* d_out, int out_size, void* d_ws, size_t ws_size, hipStream_t stream) {
    static int grid_blocks = 0;
    if (!grid_blocks) {
        if (n_in != 27 || ws_size < WS_END) { fprintf(stderr, "kernel_launch: unexpected n_in %d / ws_size %zu (need %zu)\n", n_in, ws_size, (size_t)WS_END); grid_blocks = -1; return; }
        int dev = 0, cus = 0, per_cu = 0;
        hipGetDevice(&dev);
        hipDeviceGetAttribute(&cus, hipDeviceAttributeMultiprocessorCount, dev);
        if (hipFuncSetAttribute((const void*)fwd_kernel, hipFuncAttributeMaxDynamicSharedMemorySize, LDS_BYTES) != hipSuccess) { fprintf(stderr, "kernel_launch: hipFuncSetAttribute failed\n"); grid_blocks = -1; return; }
        hipOccupancyMaxActiveBlocksPerMultiprocessor(&per_cu, (const void*)fwd_kernel, 512, LDS_BYTES);
        if (per_cu < 1) { fprintf(stderr, "kernel_launch: occupancy query says %d blocks per CU\n", per_cu); per_cu = 1; }
        (void)hipGetLastError();
        grid_blocks = cus;
        if (grid_blocks < 236) { fprintf(stderr, "kernel_launch: %d CUs: the per-phase rstd table holds 6 units per workgroup (needs >= 236 workgroups)\n", cus); grid_blocks = -1; return; }
    }
    if (grid_blocks < 0) return;
    Params p{};
    for (int i = 0; i < 27; ++i) p.in[i] = (const float*)d_in[i];
    p.out = (float*)d_out; p.ws = (unsigned char*)d_ws;
#if FUSED
    p.ph_lo = 0; p.ph_hi = N_PHASES;
    if (hipMemsetAsync((unsigned char*)d_ws + WS_BAR, 0, 16384, stream) != hipSuccess) { fprintf(stderr, "kernel_launch: memset of the barrier words failed\n"); return; }
    void* args[] = {&p};
    hipError_t e = hipLaunchCooperativeKernel((const void*)fwd_kernel, dim3(grid_blocks), dim3(512), args, LDS_BYTES, stream);
    if (e != hipSuccess) fprintf(stderr, "cooperative launch failed: %s (grid %d)\n", hipGetErrorString(e), grid_blocks);
#else
    for (int ph = 0; ph < N_PHASES; ++ph) {
        p.ph_lo = ph; p.ph_hi = ph + 1;
        hipLaunchKernelGGL(fwd_kernel, dim3(grid_blocks), dim3(512), LDS_BYTES, stream, p);
    }
#endif
}
```
